# Optimizing an MI355X kernel written in HIP

```python
import jax, jax.numpy as jnp
from jax import lax
import numpy as np

D_MODEL = 1024
BATCH = 8
SEQ = 4096
DEPTH = 1

PLE_DIM = 256
D_MIX = D_MODEL
D_CONV = D_MIX // 2
D_REC = D_MIX - D_CONV
CONV_GROUPS = 8
CONV_GROUP_DIM = D_CONV // CONV_GROUPS
CONV_WIDTH = 31
REC_HEAD_DIM = 128
N_REC_HEADS = D_REC // REC_HEAD_DIM
CHUNK = 64
D_FF = 4 * D_MODEL
D_IN_PROJ = 2 * D_CONV + 4 * D_REC
EPS = 1e-6

kernel_name = "hymba_conformer_hgrn2_hybrid"


def rmsnorm(x, g):
    xf = x.astype(jnp.float32)
    y = xf * lax.rsqrt(jnp.mean(xf * xf, axis=-1, keepdims=True) + EPS)
    return (y * g.astype(jnp.float32)).astype(x.dtype)


def group_layernorm(x, g, b):
    Bs, S, C = x.shape
    xf = x.astype(jnp.float32).reshape(Bs, S, CONV_GROUPS, CONV_GROUP_DIM)
    mu = jnp.mean(xf, axis=-1, keepdims=True)
    var = jnp.mean(jnp.square(xf - mu), axis=-1, keepdims=True)
    y = ((xf - mu) * lax.rsqrt(var + EPS)).reshape(Bs, S, C)
    return (y * g.astype(jnp.float32) + b.astype(jnp.float32)).astype(x.dtype)


def causal_depthwise_conv(x, w, b):
    C = x.shape[-1]
    y = lax.conv_general_dilated(
        x, w[:, None, :].astype(x.dtype), window_strides=(1,),
        padding=[(CONV_WIDTH - 1, 0)], dimension_numbers=("NWC", "WIO", "NWC"),
        feature_group_count=C)
    return y + b.astype(x.dtype)


def hgrn2_chunkwise(q, k, v, logf):
    Bs, S, H, dk = q.shape
    dv = v.shape[-1]
    n = S // CHUNK

    def to_chunks(t):
        return t.reshape(Bs, n, CHUNK, H, t.shape[-1]).transpose(1, 0, 3, 2, 4)

    qc, kc, vc, gc = map(to_chunks, (q, k, v, logf))
    bc = jnp.cumsum(gc, axis=3)
    causal = jnp.tril(jnp.ones((CHUNK, CHUNK), dtype=bool))[:, :, None]

    def step(state, inp):
        q_, k_, v_, b_ = inp
        diff = b_[:, :, :, None, :] - b_[:, :, None, :, :]
        decay = jnp.exp(jnp.where(causal, diff, -jnp.inf))
        attn = jnp.einsum('bhtd,bhsd,bhtsd->bhts', q_, k_, decay)
        o = (jnp.einsum('bhts,bhsv->bhtv', attn, v_)
             + jnp.einsum('bhtd,bhdv->bhtv', q_ * jnp.exp(b_), state))
        b_last = b_[:, :, -1:, :]
        new_state = (jnp.exp(b_last[:, :, 0, :])[..., None] * state
                     + jnp.einsum('bhsd,bhsv->bhdv', k_ * jnp.exp(b_last - b_), v_))
        return new_state, o

    s0 = jnp.zeros((Bs, H, dk, dv), jnp.float32)
    _, o = lax.scan(step, s0, (qc, kc, vc, bc))
    return o.transpose(1, 0, 3, 2, 4).reshape(Bs, S, H, dv)


def setup_inputs(seed: int = 0) -> dict:
    key = jax.random.key(seed)
    ks = jax.random.split(key, 20)
    f32 = jnp.float32

    def nrm(k, shape, scale):
        return jax.random.normal(k, shape, f32) * scale

    def gain(k, shape):
        return 1.0 + 0.05 * jax.random.normal(k, shape, f32)

    return {
        "x": jax.random.normal(ks[0], (BATCH, SEQ, D_MODEL), f32),
        "p": jax.random.normal(ks[1], (DEPTH, BATCH, SEQ, PLE_DIM), f32),
        "norm_mix_g": gain(ks[2], (DEPTH, D_MODEL)),
        "w_in": nrm(ks[3], (DEPTH, D_MODEL, D_IN_PROJ), D_MODEL ** -0.5),
        "conv_w": nrm(ks[4], (DEPTH, CONV_WIDTH, D_CONV), CONV_WIDTH ** -0.5),
        "conv_b": nrm(ks[5], (DEPTH, D_CONV), 0.02),
        "conv_ln_g": gain(ks[6], (DEPTH, D_CONV)),
        "conv_ln_b": nrm(ks[7], (DEPTH, D_CONV), 0.02),
        "lb_logits": gain(ks[8], (DEPTH + 1, D_REC)),
        "rec_norm_g": gain(ks[9], (DEPTH, D_REC)),
        "w_out": nrm(ks[10], (DEPTH, D_MIX, D_MODEL), D_MIX ** -0.5),
        "norm_ffn_g": gain(ks[11], (DEPTH, D_MODEL)),
        "w_up": nrm(ks[12], (DEPTH, D_MODEL, D_FF), D_MODEL ** -0.5),
        "w_down": nrm(ks[13], (DEPTH, D_FF, D_MODEL), D_FF ** -0.5),
        "w_ple": nrm(ks[14], (DEPTH, PLE_DIM, D_MODEL), PLE_DIM ** -0.5),
        "ple_norm_g": gain(ks[15], (DEPTH, D_MODEL)),
        "w_ple_gate": nrm(ks[16], (DEPTH, D_MODEL, D_MODEL), D_MODEL ** -0.5),
        "final_norm_g": gain(ks[17], (D_MODEL,)),
    }


def reference(x, p, norm_mix_g, w_in, conv_w, conv_b, conv_ln_g, conv_ln_b, lb_logits,
              rec_norm_g, w_out, norm_ffn_g, w_up, w_down, w_ple, ple_norm_g, w_ple_gate,
              final_norm_g):
    Bs, S, _ = x.shape
    lower_bounds = jnp.cumsum(jax.nn.softmax(lb_logits.astype(jnp.float32), axis=0), axis=0)
    h = x
    for l in range(DEPTH):
        u = rmsnorm(h, norm_mix_g[l])
        z = u @ w_in[l]
        conv_a, conv_b_in, q, f_pre, i_in, g = jnp.split(
            z, np.cumsum([D_CONV, D_CONV, D_REC, D_REC, D_REC]), axis=-1)

        c = conv_a * jax.nn.sigmoid(conv_b_in)
        c = causal_depthwise_conv(c, conv_w[l], conv_b[l])
        y_conv = jax.nn.silu(group_layernorm(c, conv_ln_g[l], conv_ln_b[l]))

        lb = lower_bounds[l]
        f = lb + (1.0 - lb) * jax.nn.sigmoid(f_pre.astype(jnp.float32))
        logf = jnp.log(f)
        k = 1.0 - f
        shp = (Bs, S, N_REC_HEADS, REC_HEAD_DIM)
        o = hgrn2_chunkwise(q.astype(jnp.float32).reshape(shp), k.reshape(shp),
                            i_in.astype(jnp.float32).reshape(shp), logf.reshape(shp))
        o = o * lax.rsqrt(jnp.mean(o * o, axis=-1, keepdims=True) + EPS)
        o = o.reshape(Bs, S, D_REC) * rec_norm_g[l].astype(jnp.float32)
        y_rec = (o.astype(x.dtype) * jax.nn.silu(g))

        h = h + jnp.concatenate([y_conv, y_rec], axis=-1) @ w_out[l]

        v = rmsnorm(h, norm_ffn_g[l])
        h = h + jnp.square(jax.nn.relu(v @ w_up[l])) @ w_down[l]

        h = h + rmsnorm(p[l] @ w_ple[l], ple_norm_g[l]) * jax.nn.sigmoid(h @ w_ple_gate[l])
    return rmsnorm(h, final_norm_g)
```

```cpp
#include <hip/hip_runtime.h>
#include <hip/hip_cooperative_groups.h>
#include <cstdio>
#include <cstdint>
namespace cg = cooperative_groups;
namespace pg8 {
#define PG8_LAS __attribute__((address_space(3)))
typedef unsigned short bf16_t;
typedef short bf16x8 __attribute__((ext_vector_type(8)));
typedef float f32x4 __attribute__((ext_vector_type(4)));
typedef unsigned u32x4 __attribute__((ext_vector_type(4)));
constexpr int BM = 256, BK = 64, HALF = 128, HTB = HALF * BK * 2  , STAGE_BYTES = 8 * HTB, NXCD = 8, WGM = 8;

__host__ __device__ __forceinline__ int lds_byte(int r, int c) { const int st = (r >> 4) * 2 + (c >> 5), rr = r & 15, cc = c & 31, ob = rr * 64 + cc * 2; return st * 1024 + (ob ^ (((ob >> 9) & 1) << 5)); }
__host__ __device__ __forceinline__ void stage_rc(int b, int& R, int& C) { const int st = b / 1024, sb = b % 1024, swz = sb ^ (((sb >> 9) & 1) << 5); R = (st >> 1) * 16 + swz / 64; C = (st & 1) * 32 + (swz % 64) / 2; }
__host__ __device__ __forceinline__ int perm32(int rho) { const int n = rho >> 4, i = rho & 15; return 8 * (i >> 2) + 4 * n + (i & 3); }

struct Unit { int pm, pn; };
struct Gemm { const bf16_t* A; const bf16_t* Bt; int M, N, K; };

struct StaticOrder {
    int nM, nN, nwg, G, c;
    __host__ __device__ void init(int M, int N, int G_, int c_) { nM = M / BM; nN = N / BM; nwg = nM * nN; G = G_; c = c_; }
    __host__ __device__ bool next(int i, Unit& u) const {
        const long L = (long)i * G + c; if (L >= nwg) return false;
        int wgid = (int)L; { const int q = nwg / NXCD, r = nwg % NXCD, xcd = wgid % NXCD, off = wgid / NXCD; wgid = (xcd < r ? xcd * (q + 1) : r * (q + 1) + (xcd - r) * q) + off; }
        const int nig = WGM * nN, gid = wgid / nig, fm = gid * WGM, gsz = (nM - fm) < WGM ? (nM - fm) : WGM;
        u.pm = fm + ((wgid % nig) % gsz); u.pn = (wgid % nig) / gsz; return true;
    }
    __device__ __forceinline__ void a_ready(const Unit&) const {}
    __device__ __forceinline__ void done(const Unit&) const {}
};

typedef __bf16 bf16x2_t __attribute__((ext_vector_type(2)));
typedef float f32x2_t __attribute__((ext_vector_type(2)));
__device__ __forceinline__ unsigned cvt_pk_bf16(float lo, float hi) { const f32x2_t v = {lo, hi}; const bf16x2_t b = __builtin_convertvector(v, bf16x2_t); return __builtin_bit_cast(unsigned, b); }
typedef float f32x2 __attribute__((ext_vector_type(2)));
typedef unsigned u32x2 __attribute__((ext_vector_type(2)));
__device__ __forceinline__ float sigm(float x) { return 1.0f / (1.0f + __expf(-x)); }
__device__ __forceinline__ unsigned cvt_pk_bf16_asm(float lo, float hi) { unsigned r; asm volatile("v_cvt_pk_bf16_f32 %0, %1, %2" : "=v"(r) : "v"(lo), "v"(hi)); return r; }
__device__ __forceinline__ u32x4 pack8(const f32x4& a, const f32x4& b) { u32x4 w; w.x = cvt_pk_bf16_asm(a[0], a[1]); w.y = cvt_pk_bf16_asm(a[2], a[3]); w.z = cvt_pk_bf16_asm(b[0], b[1]); w.w = cvt_pk_bf16_asm(b[2], b[3]); return w; }
__device__ __forceinline__ u32x4 pack8v(const f32x4& a, const f32x4& b) { u32x4 w; w.x = cvt_pk_bf16(a[0], a[1]); w.y = cvt_pk_bf16(a[2], a[3]); w.z = cvt_pk_bf16(b[0], b[1]); w.w = cvt_pk_bf16(b[2], b[3]); return w; }
__device__ __forceinline__ float bflo(unsigned w) { return __uint_as_float(w << 16); }
__device__ __forceinline__ float bfhi(unsigned w) { return __uint_as_float(w & 0xffff0000u); }
constexpr float EPS_ = 1e-6f;

struct EpiIn {
    static constexpr bool PERM = true, AFTER_DRAIN = false;
    const float* rstd1; const float* lbl; bf16_t* cglu; bf16_t* qb; bf16_t* gs; float* logf; bf16_t* vb;
    __device__ __forceinline__ void operator()(const f32x4 (&acc)[2][2][4][2], const Unit& u, int wr, int wc, int fr, int fq) const {
        asm volatile("s_nop 15\n\ts_nop 15" ::: "memory");
        const int kind = u.pn >> 2, j = u.pn & 3;
        const int col = j * 128 + wc * 32 + 8 * fq;
        const int row0 = u.pm * BM + wr * 64 + fr;
        if (kind == 0) {
#pragma unroll
            for (int ai = 0; ai < 2; ++ai)
#pragma unroll
                for (int m = 0; m < 4; ++m) { const int row = row0 + ai * HALF + m * 16; const float r = rstd1[row];
                    f32x4 a0 = acc[ai][0][m][0] * r, a1 = acc[ai][0][m][1] * r, b0 = acc[ai][1][m][0] * r, b1 = acc[ai][1][m][1] * r;
#pragma unroll
                    for (int e = 0; e < 4; ++e) { a0[e] *= sigm(b0[e]); a1[e] *= sigm(b1[e]); }
                    *(u32x4*)(cglu + (size_t)row * 512 + col) = pack8(a0, a1); }
        } else if (kind == 1) {
#pragma unroll
            for (int ai = 0; ai < 2; ++ai)
#pragma unroll
                for (int m = 0; m < 4; ++m) { const int row = row0 + ai * HALF + m * 16; const float r = rstd1[row];
                    f32x4 a0 = acc[ai][0][m][0] * r, a1 = acc[ai][0][m][1] * r, b0 = acc[ai][1][m][0] * r, b1 = acc[ai][1][m][1] * r;
#pragma unroll
                    for (int e = 0; e < 4; ++e) { b0[e] *= sigm(b0[e]); b1[e] *= sigm(b1[e]); }
                    *(u32x4*)(qb + (size_t)row * 512 + col) = pack8(a0, a1);
                    *(u32x4*)(gs + (size_t)row * 512 + col) = pack8(b0, b1); }
        } else {
            float lb[8];
#pragma unroll
            for (int e = 0; e < 8; ++e) lb[e] = 1.0f / (1.0f + __expf(lbl[512 + col + e] - lbl[col + e]));
#pragma unroll
            for (int ai = 0; ai < 2; ++ai)
#pragma unroll
                for (int m = 0; m < 4; ++m) { const int row = row0 + ai * HALF + m * 16; const float r = rstd1[row];
                    f32x4 a0 = acc[ai][0][m][0] * r, a1 = acc[ai][0][m][1] * r, b0 = acc[ai][1][m][0] * r, b1 = acc[ai][1][m][1] * r;
#pragma unroll
                    for (int e = 0; e < 4; ++e) { a0[e] = __logf(lb[e] + (1.0f - lb[e]) * sigm(a0[e])); a1[e] = __logf(lb[4 + e] + (1.0f - lb[4 + e]) * sigm(a1[e])); }
                    *(f32x4*)(logf + (size_t)row * 512 + col) = a0; *(f32x4*)(logf + (size_t)row * 512 + col + 4) = a1;
                    *(u32x4*)(vb + (size_t)row * 512 + col) = pack8(b0, b1); }
        }
    }
};
struct EpiPle {
    static constexpr bool PERM = true, AFTER_DRAIN = false;
    bf16_t* e; float* ssq;
    __device__ __forceinline__ void operator()(const f32x4 (&acc)[2][2][4][2], const Unit& u, int wr, int wc, int fr, int fq) const {
        asm volatile("s_nop 15\n\ts_nop 15" ::: "memory");
        const int row0 = u.pm * BM + wr * 64 + fr, col0 = u.pn * BM + wc * 32 + 8 * fq;
#pragma unroll
        for (int ai = 0; ai < 2; ++ai)
#pragma unroll
            for (int m = 0; m < 4; ++m) { const int row = row0 + ai * HALF + m * 16; float ss = 0.f;
#pragma unroll
                for (int bj = 0; bj < 2; ++bj) { const f32x4 a0 = acc[ai][bj][m][0], a1 = acc[ai][bj][m][1];
                    *(u32x4*)(e + (size_t)row * 1024 + col0 + bj * HALF) = pack8(a0, a1);
                    ss += (a0[0] * a0[0] + a0[1] * a0[1]) + (a0[2] * a0[2] + a0[3] * a0[3]) + (a1[0] * a1[0] + a1[1] * a1[1]) + (a1[2] * a1[2] + a1[3] * a1[3]); }
                ss += __shfl_xor(ss, 16); ss += __shfl_xor(ss, 32);
                if (fq == 0) __hip_atomic_fetch_add(ssq + row, ss, __ATOMIC_RELAXED, __HIP_MEMORY_SCOPE_AGENT); }
    }
};
struct EpiOut {
    static constexpr bool PERM = true, AFTER_DRAIN = false;
    const float* x; float* h; bf16_t* hb; float* ssq;
    __device__ __forceinline__ void operator()(const f32x4 (&acc)[2][2][4][2], const Unit& u, int wr, int wc, int fr, int fq) const {
        asm volatile("s_nop 15\n\ts_nop 15" ::: "memory");
        const int row0 = u.pm * BM + wr * 64 + fr, col0 = u.pn * BM + wc * 32 + 8 * fq;
#pragma unroll
        for (int ai = 0; ai < 2; ++ai)
#pragma unroll
            for (int m = 0; m < 4; ++m) { const int row = row0 + ai * HALF + m * 16; float ss = 0.f;
#pragma unroll
                for (int bj = 0; bj < 2; ++bj) { const size_t off = (size_t)row * 1024 + col0 + bj * HALF;
                    const f32x4 a0 = *(const f32x4*)(x + off) + acc[ai][bj][m][0], a1 = *(const f32x4*)(x + off + 4) + acc[ai][bj][m][1];
                    *(f32x4*)(h + off) = a0; *(f32x4*)(h + off + 4) = a1; *(u32x4*)(hb + off) = pack8(a0, a1);
                    ss += (a0[0] * a0[0] + a0[1] * a0[1]) + (a0[2] * a0[2] + a0[3] * a0[3]) + (a1[0] * a1[0] + a1[1] * a1[1]) + (a1[2] * a1[2] + a1[3] * a1[3]); }
                ss += __shfl_xor(ss, 16); ss += __shfl_xor(ss, 32);
                if (fq == 0) __hip_atomic_fetch_add(ssq + row, ss, __ATOMIC_RELAXED, __HIP_MEMORY_SCOPE_AGENT);
                asm volatile("" ::: "memory"); }
    }
};
struct EpiUp {
    static constexpr bool PERM = true, AFTER_DRAIN = false;
    bf16_t* t;
    __device__ __forceinline__ void operator()(const f32x4 (&acc)[2][2][4][2], const Unit& u, int wr, int wc, int fr, int fq) const {
        asm volatile("s_nop 15\n\ts_nop 15" ::: "memory");
        const int row0 = u.pm * BM + wr * 64 + fr, col0 = u.pn * BM + wc * 32 + 8 * fq;
#pragma unroll
        for (int ai = 0; ai < 2; ++ai)
#pragma unroll
            for (int m = 0; m < 4; ++m) { const int row = row0 + ai * HALF + m * 16;
#pragma unroll
                for (int bj = 0; bj < 2; ++bj) { f32x4 a0 = acc[ai][bj][m][0], a1 = acc[ai][bj][m][1];
#pragma unroll
                    for (int e = 0; e < 4; ++e) { const float p = fmaxf(a0[e], 0.f), q = fmaxf(a1[e], 0.f); a0[e] = p * p; a1[e] = q * q; }
                    *(u32x4*)(t + (size_t)row * 4096 + col0 + bj * HALF) = pack8(a0, a1); } }
    }
};
struct EpiDown {
    static constexpr bool PERM = true, AFTER_DRAIN = false;
    const float* ssq2; float* h; bf16_t* hb;
    __device__ __forceinline__ void operator()(const f32x4 (&acc)[2][2][4][2], const Unit& u, int wr, int wc, int fr, int fq) const {
        asm volatile("s_nop 15\n\ts_nop 15" ::: "memory");
        const int row0 = u.pm * BM + wr * 64 + fr, col0 = u.pn * BM + wc * 32 + 8 * fq;
#pragma unroll
        for (int ai = 0; ai < 2; ++ai)
#pragma unroll
            for (int m = 0; m < 4; ++m) { const int row = row0 + ai * HALF + m * 16; const float r2 = 1.0f / (ssq2[row] * (1.0f / 1024.0f) + EPS_);
#pragma unroll
                for (int bj = 0; bj < 2; ++bj) { const size_t off = (size_t)row * 1024 + col0 + bj * HALF;
                    const f32x4 a0 = *(const f32x4*)(h + off) + acc[ai][bj][m][0] * r2, a1 = *(const f32x4*)(h + off + 4) + acc[ai][bj][m][1] * r2;
                    *(f32x4*)(h + off) = a0; *(f32x4*)(h + off + 4) = a1; *(u32x4*)(hb + off) = pack8(a0, a1); }
                asm volatile("" ::: "memory"); }
    }
};
struct EpiGate {
    static constexpr bool PERM = true, AFTER_DRAIN = false;
    float* h; const bf16_t* e; const float* ssqE; const float* gple; float* ssq3;
    __device__ __forceinline__ void operator()(const f32x4 (&acc)[2][2][4][2], const Unit& u, int wr, int wc, int fr, int fq) const {
        asm volatile("s_nop 15\n\ts_nop 15" ::: "memory");
        const int row0 = u.pm * BM + wr * 64 + fr, col0 = u.pn * BM + wc * 32 + 8 * fq;
        f32x4 gp[2][2];
#pragma unroll
        for (int bj = 0; bj < 2; ++bj) { gp[bj][0] = *(const f32x4*)(gple + col0 + bj * HALF); gp[bj][1] = *(const f32x4*)(gple + col0 + bj * HALF + 4); }
#pragma unroll
        for (int ai = 0; ai < 2; ++ai)
#pragma unroll
            for (int m = 0; m < 4; ++m) { const int row = row0 + ai * HALF + m * 16; const float rE = __builtin_amdgcn_rsqf(ssqE[row] * (1.0f / 1024.0f) + EPS_); float ss = 0.f;
#pragma unroll
                for (int bj = 0; bj < 2; ++bj) { const size_t off = (size_t)row * 1024 + col0 + bj * HALF;
                    const u32x4 ev = *(const u32x4*)(e + off);
                    f32x4 e0 = {bflo(ev.x), bfhi(ev.x), bflo(ev.y), bfhi(ev.y)}, e1 = {bflo(ev.z), bfhi(ev.z), bflo(ev.w), bfhi(ev.w)};
                    f32x4 s0 = acc[ai][bj][m][0], s1 = acc[ai][bj][m][1];
#pragma unroll
                    for (int k = 0; k < 4; ++k) { s0[k] = sigm(s0[k]); s1[k] = sigm(s1[k]); }
                    const f32x4 a0 = *(const f32x4*)(h + off) + e0 * rE * gp[bj][0] * s0, a1 = *(const f32x4*)(h + off + 4) + e1 * rE * gp[bj][1] * s1;
                    *(f32x4*)(h + off) = a0; *(f32x4*)(h + off + 4) = a1;
                    ss += (a0[0] * a0[0] + a0[1] * a0[1]) + (a0[2] * a0[2] + a0[3] * a0[3]) + (a1[0] * a1[0] + a1[1] * a1[1]) + (a1[2] * a1[2] + a1[3] * a1[3]); }
                ss += __shfl_xor(ss, 16); ss += __shfl_xor(ss, 32);
                if (fq == 0) __hip_atomic_fetch_add(ssq3 + row, ss, __ATOMIC_RELAXED, __HIP_MEMORY_SCOPE_AGENT);
                asm volatile("" ::: "memory"); }
    }
};

template <class Epi, class Sched, bool ALIGN_EPI = false, bool SP2 = false>
__device__ __forceinline__ void gemm_phase(PG8_LAS unsigned char* lds, const Gemm g, const Sched& S, const Epi& E) {
    const int tid = threadIdx.x, wid = __builtin_amdgcn_readfirstlane(tid >> 6), lane = tid & 63, wr = wid >> 2, wc = wid & 3, fr = lane & 15, fq = lane >> 4;
    const int K = g.K, nt = K / BK;
    unsigned voffA[2], voffB[2];
#pragma unroll
    for (int i = 0; i < 2; ++i) { int R, C; stage_rc(tid * 16 + i * 8192, R, C); const int Rb = Epi::PERM ? ((R & ~31) + perm32(R & 31)) : R;
        voffA[i] = (unsigned)(R * K + C) * 2u; voffB[i] = (unsigned)(Rb * K + C) * 2u; }
    const size_t kstep = (size_t)(BK * 2);
    const size_t hstep = (size_t)HALF * K * 2;
    const size_t tstep = 2 * hstep;
    const unsigned ldsw = (unsigned)wid * 1024u;
    const int aoff = lds_byte(wr * 64 + fr, fq * 8), boff = lds_byte(wc * 32 + fr, fq * 8);
#define PG8_SA(b, h) (((b) * 2 + (h)) * HTB)
#define PG8_SB(b, h) ((4 + (b) * 2 + (h)) * HTB)
#define PG8_STAGE(bufoff, gbase, voff) do { _Pragma("unroll") for (int _i = 0; _i < 2; ++_i) \
        __builtin_amdgcn_global_load_lds((const unsigned*)((const char*)(gbase) + (voff)[_i]), (PG8_LAS unsigned*)(lds + (bufoff) + ldsw + _i * 8192), 16, 0, 0); } while (0)
#define PG8_LDA(dst, b, h) do { _Pragma("unroll") for (int m = 0; m < 4; ++m) _Pragma("unroll") for (int k = 0; k < 2; ++k) dst[m][k] = *(const PG8_LAS bf16x8*)(lds + PG8_SA(b, h) + aoff + m * 2048 + k * 1024); } while (0)
#define PG8_LDB(dst, b, h) do { _Pragma("unroll") for (int n = 0; n < 2; ++n) _Pragma("unroll") for (int k = 0; k < 2; ++k) dst[n][k] = *(const PG8_LAS bf16x8*)(lds + PG8_SB(b, h) + boff + n * 2048 + k * 1024); } while (0)
#define PG8_MMA(ai, bj, At, Bt) do { __builtin_amdgcn_s_setprio(1); _Pragma("unroll") for (int m = 0; m < 4; ++m) _Pragma("unroll") for (int n = 0; n < 2; ++n) _Pragma("unroll") for (int k = 0; k < 2; ++k) \
        acc[ai][bj][m][n] = __builtin_amdgcn_mfma_f32_16x16x32_bf16(Bt[n][k], At[m][k], acc[ai][bj][m][n], 0, 0, 0); __builtin_amdgcn_s_setprio(0); } while (0)
#define PG8_WAIT_V(n) asm volatile("s_waitcnt vmcnt(" #n ")" ::: "memory")
#define PG8_WAIT_L(n) asm volatile("s_waitcnt lgkmcnt(" #n ")" ::: "memory")
#define PG8_BAR __builtin_amdgcn_s_barrier()
#define PG8_SCHED __builtin_amdgcn_sched_barrier(0)
    Unit cur, nxt; int ui = 0;
    if (!S.next(0, cur)) return;
    f32x4 acc[2][2][4][2];
#pragma unroll
    for (int a = 0; a < 2; ++a)
#pragma unroll
        for (int b = 0; b < 2; ++b)
#pragma unroll
            for (int m = 0; m < 4; ++m)
#pragma unroll
                for (int n = 0; n < 2; ++n) acc[a][b][m][n] = (f32x4){0.f, 0.f, 0.f, 0.f};
    bf16x8 At[4][2], B0[2][2], B1[2][2];
    const char* cA = (const char*)g.A + (size_t)cur.pm * tstep; const char* cB = (const char*)g.Bt + (size_t)cur.pn * tstep;
    S.a_ready(cur);
    if constexpr (SP2) {
        PG8_STAGE(PG8_SB(0, 0), cB, voffB); PG8_STAGE(PG8_SB(0, 1), cB + hstep, voffB); PG8_STAGE(PG8_SA(0, 0), cA, voffA); PG8_STAGE(PG8_SA(0, 1), cA + hstep, voffA);
        if (wr == 1) PG8_BAR;
        PG8_WAIT_V(2); PG8_BAR;
        PG8_STAGE(PG8_SB(1, 0), cB + kstep, voffB); PG8_STAGE(PG8_SA(1, 0), cA + kstep, voffA); PG8_STAGE(PG8_SB(1, 1), cB + hstep + kstep, voffB);
        PG8_WAIT_V(6); PG8_BAR;
    } else {
        PG8_STAGE(PG8_SB(0, 0), cB, voffB); PG8_STAGE(PG8_SA(0, 0), cA, voffA); PG8_STAGE(PG8_SB(0, 1), cB + hstep, voffB); PG8_STAGE(PG8_SA(0, 1), cA + hstep, voffA);
        if (wr == 1) PG8_BAR;
        PG8_WAIT_V(4); PG8_BAR;
        PG8_STAGE(PG8_SB(1, 0), cB + kstep, voffB); PG8_STAGE(PG8_SA(1, 0), cA + kstep, voffA); PG8_STAGE(PG8_SB(1, 1), cB + hstep + kstep, voffB);
        PG8_WAIT_V(6); PG8_BAR;
    }
    for (;;) {
        const bool has_next = S.next(ui + 1, nxt);
        const char* nA = has_next ? (const char*)g.A + (size_t)nxt.pm * tstep : cA; const char* nB = has_next ? (const char*)g.Bt + (size_t)nxt.pn * tstep : cB;
        for (int t = 0; t < nt; t += 2) {
            const bool last = (t == nt - 2);
            const char* a1 = cA + (size_t)(t + 1) * kstep;
            const char* a2 = last ? nA : cA + (size_t)(t + 2) * kstep; const char* b2 = last ? nB : cB + (size_t)(t + 2) * kstep;
            const char* a3 = a2 + kstep; const char* b3 = b2 + kstep;
            if (last && has_next) S.a_ready(nxt);
            if constexpr (SP2) {
            PG8_LDB(B0, 0, 0); PG8_LDB(B1, 0, 1); PG8_SCHED; PG8_LDA(At, 0, 0); PG8_STAGE(PG8_SA(1, 1), a1 + hstep, voffA);
            PG8_WAIT_V(8); PG8_WAIT_L(0); PG8_BAR; PG8_MMA(0, 0, At, B0); PG8_MMA(0, 1, At, B1); PG8_BAR; PG8_SCHED;
            PG8_LDA(At, 0, 1); PG8_STAGE(PG8_SB(0, 0), b2, voffB); PG8_STAGE(PG8_SB(0, 1), b2 + hstep, voffB); PG8_STAGE(PG8_SA(0, 0), a2, voffA);
            PG8_WAIT_V(8); PG8_WAIT_L(0); PG8_BAR; PG8_MMA(1, 0, At, B0); PG8_MMA(1, 1, At, B1); PG8_BAR; PG8_SCHED;
            PG8_LDB(B0, 1, 0); PG8_LDB(B1, 1, 1); PG8_SCHED; PG8_LDA(At, 1, 0); PG8_STAGE(PG8_SA(0, 1), a2 + hstep, voffA);
            PG8_WAIT_V(8); PG8_WAIT_L(0); PG8_BAR; PG8_MMA(0, 0, At, B0); PG8_MMA(0, 1, At, B1); PG8_BAR; PG8_SCHED;
            PG8_LDA(At, 1, 1); PG8_STAGE(PG8_SB(1, 0), b3, voffB); PG8_STAGE(PG8_SB(1, 1), b3 + hstep, voffB); PG8_STAGE(PG8_SA(1, 0), a3, voffA);
            PG8_WAIT_V(8); PG8_WAIT_L(0); PG8_BAR; PG8_MMA(1, 0, At, B0); PG8_MMA(1, 1, At, B1); PG8_BAR; PG8_SCHED;
            } else {
            PG8_LDB(B0, 0, 0); PG8_SCHED; PG8_LDA(At, 0, 0); PG8_STAGE(PG8_SA(1, 1), a1 + hstep, voffA);
            PG8_WAIT_L(8); PG8_BAR; PG8_WAIT_L(0); PG8_MMA(0, 0, At, B0); PG8_BAR; PG8_SCHED;
            PG8_LDB(B1, 0, 1); PG8_STAGE(PG8_SB(0, 0), b2, voffB);
            PG8_BAR; PG8_WAIT_L(0); PG8_MMA(0, 1, At, B1); PG8_BAR;
            PG8_LDA(At, 0, 1); PG8_STAGE(PG8_SA(0, 0), a2, voffA);
            PG8_BAR; PG8_WAIT_L(0); PG8_MMA(1, 0, At, B0); PG8_BAR; PG8_SCHED;
            PG8_STAGE(PG8_SB(0, 1), b2 + hstep, voffB);
            PG8_WAIT_V(6); PG8_BAR; PG8_MMA(1, 1, At, B1); PG8_BAR;
            PG8_LDB(B0, 1, 0); PG8_SCHED; PG8_LDA(At, 1, 0); PG8_STAGE(PG8_SA(0, 1), a2 + hstep, voffA);
            PG8_WAIT_L(8); PG8_BAR; PG8_WAIT_L(0); PG8_MMA(0, 0, At, B0); PG8_BAR; PG8_SCHED;
            PG8_LDB(B1, 1, 1); PG8_STAGE(PG8_SB(1, 0), b3, voffB);
            PG8_BAR; PG8_WAIT_L(0); PG8_MMA(0, 1, At, B1); PG8_BAR;
            PG8_LDA(At, 1, 1); PG8_STAGE(PG8_SA(1, 0), a3, voffA);
            PG8_BAR; PG8_WAIT_L(0); PG8_MMA(1, 0, At, B0); PG8_BAR; PG8_SCHED;
            PG8_STAGE(PG8_SB(1, 1), b3 + hstep, voffB);
            PG8_WAIT_V(6); PG8_BAR; PG8_MMA(1, 1, At, B1); PG8_BAR;
            }
        }
        if constexpr (ALIGN_EPI) { if (wr == 0) PG8_BAR; }
        if constexpr (!Epi::AFTER_DRAIN) { E(acc, cur, wr, wc, fr, fq); S.done(cur); }
        if (!has_next) break;
#pragma unroll
        for (int a = 0; a < 2; ++a)
#pragma unroll
            for (int b = 0; b < 2; ++b)
#pragma unroll
                for (int m = 0; m < 4; ++m)
#pragma unroll
                    for (int n = 0; n < 2; ++n) acc[a][b][m][n] = (f32x4){0.f, 0.f, 0.f, 0.f};
        cur = nxt; cA = nA; cB = nB; ++ui;
        if constexpr (ALIGN_EPI) { if (wr == 1) PG8_BAR; }
    }
    PG8_WAIT_V(0);
    if constexpr (!ALIGN_EPI) { if (wr == 0) PG8_BAR; }
    PG8_BAR;
    if constexpr (Epi::AFTER_DRAIN) { E.fused(acc, cur, wr, wc, fr, fq, lds, wid, lane); S.done(cur); }
#undef PG8_SA
#undef PG8_SB
#undef PG8_STAGE
#undef PG8_LDA
#undef PG8_LDB
#undef PG8_MMA
#undef PG8_WAIT_V
#undef PG8_WAIT_L
#undef PG8_BAR
#undef PG8_SCHED
}
}

#define LAS __attribute__((address_space(3)))
typedef unsigned short bf16_t;
typedef short bf16x8 __attribute__((ext_vector_type(8)));
typedef float f32x4 __attribute__((ext_vector_type(4)));
typedef unsigned u32x4 __attribute__((ext_vector_type(4)));
typedef unsigned u32x2 __attribute__((ext_vector_type(2)));
using pg8::cvt_pk_bf16; using pg8::bflo; using pg8::bfhi; using pg8::sigm;

#ifndef MK_COOP
#define MK_COOP 1
#endif
constexpr int NWAVES = 8, NTHR = 512;
constexpr int BATCH = 8, SEQ = 4096, D = 1024, M = BATCH * SEQ, DIN = 3072, FF = 4096, PLE = 256, DC = 512, DR = 512, NH = 4, HD = 128, CH = 64, NCHUNK = SEQ / CH;
constexpr int NUNIT = BATCH * NH * NCHUNK;
constexpr float EPS = 1e-6f;
constexpr int N_PHASES = 10;
constexpr size_t MiB = 1u << 20;
constexpr size_t WS_RSTD1 = 0, WS_SSQ2 = 128 * 1024, WS_SSQE = 256 * 1024, WS_SSQ3 = 384 * 1024, WS_DEC = 1 * MiB;
constexpr size_t WS_WIN = 2 * MiB, WS_WOUT = 8 * MiB, WS_WUP = 10 * MiB, WS_WDOWN = 18 * MiB, WS_WPLE = 26 * MiB, WS_WGATE = 27 * MiB;
constexpr size_t WS_XB = 32 * MiB;
constexpr size_t WS_PB = 96 * MiB;
constexpr size_t WS_CGLU = 112 * MiB, WS_QB = 144 * MiB, WS_GS = 176 * MiB, WS_LOGF = 208 * MiB, WS_VB = 272 * MiB, WS_UT = 304 * MiB;
constexpr size_t WS_T = 112 * MiB;
constexpr size_t WS_Y = 368 * MiB;
constexpr size_t WS_E = 432 * MiB;
constexpr size_t WS_END = 496 * MiB;
constexpr int LDS_BYTES = 147456;

__device__ __forceinline__ float wave_sum(float v) {
#pragma unroll
    for (int o = 1; o < 64; o <<= 1) v += __shfl_xor(v, o);
    return v;
}
#define LDS_WAIT() asm volatile("s_waitcnt lgkmcnt(0)" ::: "memory")

__device__ __forceinline__ void transpose_item(const float* W, int K, int N, bf16_t* WT, int mode, const float* gain, LAS float* scr, int item, int lane) {
    const int nblk = N / 32, kb = item / nblk, nb = item % nblk, k0 = 64 * kb, n0 = 32 * nb;
#pragma unroll 8
    for (int i = 0; i < 32; ++i) { const int kk = 2 * i + (lane >> 5); float w = W[(size_t)(k0 + kk) * N + n0 + (lane & 31)]; if (gain) w *= gain[k0 + kk]; scr[kk * 33 + (lane & 31)] = w; }
    LDS_WAIT();
    int drow0 = n0;
    if (mode == 1) { const int region = n0 >> 9, within = n0 & 511, j = within >> 7, c0 = within & 127;
        int tile, bj;
        switch (region) { case 0: tile = j; bj = 0; break; case 1: tile = j; bj = 1; break; case 2: tile = 4 + j; bj = 0; break;
                          case 3: tile = 8 + j; bj = 0; break; case 4: tile = 8 + j; bj = 1; break; default: tile = 4 + j; bj = 1; break; }
        drow0 = tile * 256 + bj * 128 + c0; }
    const int c = lane & 7;
#pragma unroll
    for (int j = 0; j < 4; ++j) { const int n = (lane >> 3) + 8 * j; const LAS float* s = scr + (8 * c) * 33 + n;
        u32x4 o; o.x = cvt_pk_bf16(s[0 * 33], s[1 * 33]); o.y = cvt_pk_bf16(s[2 * 33], s[3 * 33]); o.z = cvt_pk_bf16(s[4 * 33], s[5 * 33]); o.w = cvt_pk_bf16(s[6 * 33], s[7 * 33]);
        *(u32x4*)(WT + (size_t)(drow0 + n) * K + k0 + 8 * c) = o; }
    LDS_WAIT();
}

struct Args { const float* in[18]; float* out; unsigned char* ws; int ph_lo, ph_hi; };

__global__ void __launch_bounds__(NTHR, 2) mk_fwd(Args args) {
    extern __shared__ __attribute__((aligned(16))) unsigned char lds_raw[];
    LAS unsigned char* lds = (LAS unsigned char*)lds_raw;
    cg::grid_group grid = cg::this_grid();
    const int tid = threadIdx.x, lane = tid & 63, wave = __builtin_amdgcn_readfirstlane(tid >> 6);
    const int G = gridDim.x, gw = blockIdx.x * NWAVES + wave, NGW = G * NWAVES;
    const int lo = args.ph_lo, hi = args.ph_hi;
    unsigned char* const ws = args.ws;
#define xin (args.in[0])
#define outp (args.out)
#define rstd1 ((float*)(ws + WS_RSTD1))
#define ssq2 ((float*)(ws + WS_SSQ2))
#define ssqE ((float*)(ws + WS_SSQE))
#define ssq3 ((float*)(ws + WS_SSQ3))
#define dec ((float*)(ws + WS_DEC))
#define WinT ((bf16_t*)(ws + WS_WIN))
#define WoutT ((bf16_t*)(ws + WS_WOUT))
#define WupT ((bf16_t*)(ws + WS_WUP))
#define WdownT ((bf16_t*)(ws + WS_WDOWN))
#define WpleT ((bf16_t*)(ws + WS_WPLE))
#define WgateT ((bf16_t*)(ws + WS_WGATE))
#define xb ((bf16_t*)(ws + WS_XB))
#define pb ((bf16_t*)(ws + WS_PB))
#define cglu ((bf16_t*)(ws + WS_CGLU))
#define qb ((bf16_t*)(ws + WS_QB))
#define gs ((bf16_t*)(ws + WS_GS))
#define logf ((float*)(ws + WS_LOGF))
#define vb ((bf16_t*)(ws + WS_VB))
#define Ut ((bf16_t*)(ws + WS_UT))
#define tb ((bf16_t*)(ws + WS_T))
#define yb ((bf16_t*)(ws + WS_Y))
#define eb ((bf16_t*)(ws + WS_E))
#define IN(k) (lo <= (k) && (k) < hi)
#define SEAM(k) do { if (IN(k) && IN((k) + 1)) grid.sync(); } while (0)

    if (IN(0)) {
        LAS float* scr = (LAS float*)(lds + wave * 16384);
        constexpr int I_IN = (D / 64) * (DIN / 32), I_OUT = (D / 64) * (D / 32), I_UP = (D / 64) * (FF / 32), I_DOWN = (FF / 64) * (D / 32), I_PLE = (PLE / 64) * (D / 32), I_GATE = I_OUT;
        constexpr int NITEMS = I_IN + I_OUT + I_UP + I_DOWN + I_PLE + I_GATE;
        for (int it = gw; it < NITEMS; it += NGW) {
            int r = it;
            if (r < I_IN) { transpose_item(args.in[3], D, DIN, WinT, 1, args.in[2], scr, r, lane); continue; } r -= I_IN;
            if (r < I_OUT) { transpose_item(args.in[10], D, D, WoutT, 0, nullptr, scr, r, lane); continue; } r -= I_OUT;
            if (r < I_UP) { transpose_item(args.in[12], D, FF, WupT, 0, args.in[11], scr, r, lane); continue; } r -= I_UP;
            if (r < I_DOWN) { transpose_item(args.in[13], FF, D, WdownT, 0, nullptr, scr, r, lane); continue; } r -= I_DOWN;
            if (r < I_PLE) { transpose_item(args.in[14], PLE, D, WpleT, 0, nullptr, scr, r, lane); continue; } r -= I_PLE;
            transpose_item(args.in[16], D, D, WgateT, 0, nullptr, scr, r, lane);
        }
        for (int m = gw; m < M; m += NGW) {
            const f32x4* xr = (const f32x4*)(xin + (size_t)m * D) + lane; f32x4 v[4]; float s = 0.f;
#pragma unroll
            for (int j = 0; j < 4; ++j) { v[j] = xr[64 * j]; s += (v[j][0] * v[j][0] + v[j][1] * v[j][1]) + (v[j][2] * v[j][2] + v[j][3] * v[j][3]); }
            s = wave_sum(s);
            if (lane == 0) rstd1[m] = __builtin_amdgcn_rsqf(s * (1.0f / D) + EPS);
            u32x2* o8 = (u32x2*)(xb + (size_t)m * D) + lane;
#pragma unroll
            for (int j = 0; j < 4; ++j) { u32x2 w; w.x = cvt_pk_bf16(v[j][0], v[j][1]); w.y = cvt_pk_bf16(v[j][2], v[j][3]); o8[64 * j] = w; }
            const f32x4 pv = *((const f32x4*)(args.in[1] + (size_t)m * PLE) + lane);
            u32x2 w; w.x = cvt_pk_bf16(pv[0], pv[1]); w.y = cvt_pk_bf16(pv[2], pv[3]); *((u32x2*)(pb + (size_t)m * PLE) + lane) = w;
        }
        for (int i = blockIdx.x * NTHR + tid; i < M; i += G * NTHR) { ssq2[i] = 0.f; ssqE[i] = 0.f; ssq3[i] = 0.f; }
        __syncthreads();
    }
    SEAM(0);

    if (IN(1)) {
        { pg8::Gemm g{xb, WinT, M, DIN, D}; pg8::StaticOrder S; S.init(M, DIN, G, (int)blockIdx.x);
          pg8::EpiIn E{rstd1, args.in[8], cglu, qb, gs, logf, vb};
          pg8::gemm_phase<pg8::EpiIn, pg8::StaticOrder, true, true>(lds, g, S, E); }
        { pg8::Gemm g{pb, WpleT, M, D, PLE}; pg8::StaticOrder S; S.init(M, D, G, (int)blockIdx.x);
          pg8::EpiPle E{eb, ssqE};
          pg8::gemm_phase<pg8::EpiPle, pg8::StaticOrder, true, true>(lds, g, S, E); }
    }
    SEAM(1);

    if (IN(2)) {
        {
            LAS bf16_t* Xs = (LAS bf16_t*)(lds + wave * 12288);
            const float* cw = args.in[4]; const float* cbias = args.in[5]; const float* lng = args.in[6]; const float* lnb = args.in[7];
            for (int uidx = gw; uidx < (M / 64) * 8; uidx += NGW) {
                const int tile = uidx >> 3, g8 = uidx & 7, b = tile >> 6, t0 = (tile & 63) * 64;
                const int rr = lane >> 3, c16 = lane & 7;
#pragma unroll
                for (int it = 0; it < 12; ++it) { const int i = it * 8 + rr; const int t = t0 - 30 + i;
                    if (i < 94) { u32x4 v = {0u, 0u, 0u, 0u}; if (t >= 0) v = *(const u32x4*)(cglu + ((size_t)b * SEQ + t) * DC + g8 * 64 + c16 * 8);
                        *(LAS u32x4*)(Xs + i * 64 + c16 * 8) = v; } }
                float wj[31];
#pragma unroll
                for (int j = 0; j < 31; ++j) wj[j] = cw[j * DC + g8 * 64 + lane];
                const float bias = cbias[g8 * 64 + lane], gg = lng[g8 * 64 + lane], bb = lnb[g8 * 64 + lane];
                LDS_WAIT();
                for (int tblk = 0; tblk < 8; ++tblk) {
                    float xs[38];
#pragma unroll
                    for (int i = 0; i < 38; ++i) xs[i] = __uint_as_float((unsigned)Xs[(tblk * 8 + i) * 64 + lane] << 16);
#pragma unroll
                    for (int o = 0; o < 8; ++o) { float a = bias;
#pragma unroll
                        for (int j = 0; j < 31; ++j) a += wj[j] * xs[o + j];
                        const float mu = wave_sum(a) * (1.0f / 64.0f), dlt = a - mu; const float var = wave_sum(dlt * dlt) * (1.0f / 64.0f);
                        float yv = dlt * __builtin_amdgcn_rsqf(var + EPS) * gg + bb; yv = yv * sigm(yv);
                        yb[((size_t)b * SEQ + t0 + tblk * 8 + o) * D + g8 * 64 + lane] = (bf16_t)(cvt_pk_bf16(yv, 0.f) & 0xffffu); }
                }
                LDS_WAIT();
            }
        }
        __syncthreads();
        {
            LAS bf16_t* Kt = (LAS bf16_t*)(lds);
            LAS bf16_t* Vt = (LAS bf16_t*)(lds + 18432);
            LAS float* PT = (LAS float*)(lds + 36864);
            const int d = tid & 127, part = tid >> 7, l15 = lane & 15, lq = lane >> 4;
            for (int unit = blockIdx.x; unit < NUNIT; unit += G) {
                const int c = unit & 63, bh = unit >> 6, h = bh & 3, b = bh >> 2; const size_t r0 = (size_t)b * SEQ + 64 * c;
                float lf[16];
#pragma unroll
                for (int i = 0; i < 16; ++i) lf[i] = logf[(r0 + 16 * part + i) * DR + h * HD + d];
                u32x4 vv[2];
#pragma unroll
                for (int it = 0; it < 2; ++it) { const int idx = tid + 512 * it, s = idx >> 4, e8 = idx & 15; vv[it] = *(const u32x4*)(vb + (r0 + s) * DR + h * HD + e8 * 8); }
                float bc[16]; float run = 0.f;
#pragma unroll
                for (int i = 0; i < 16; ++i) { run += lf[i]; bc[i] = run; }
                PT[part * 128 + d] = run;
#pragma unroll
                for (int it = 0; it < 2; ++it) { const int idx = tid + 512 * it, s = idx >> 4, e8 = idx & 15;
#pragma unroll
                    for (int j = 0; j < 4; ++j) { const unsigned w = vv[it][j]; Vt[(e8 * 8 + 2 * j) * 72 + s] = (bf16_t)(w & 0xffffu); Vt[(e8 * 8 + 2 * j + 1) * 72 + s] = (bf16_t)(w >> 16); } }
                __syncthreads();
                float off = 0.f;
#pragma unroll
                for (int p = 0; p < 3; ++p) off += (p < part) ? PT[p * 128 + d] : 0.f;
#pragma unroll
                for (int i = 0; i < 16; i += 2) { const float b0 = bc[i] + off, b1 = bc[i + 1] + off;
                    const float k0 = (1.0f - __expf(lf[i])) * __expf(-b0), k1 = (1.0f - __expf(lf[i + 1])) * __expf(-b1);
                    *(LAS unsigned*)(Kt + d * 72 + 16 * part + i) = cvt_pk_bf16(k0, k1); }
                if (part == 3) dec[(size_t)unit * HD + d] = __expf(bc[15] + off);
                __syncthreads();
                const int d0 = 16 * wave;
                bf16x8 a[2];
#pragma unroll
                for (int kk = 0; kk < 2; ++kk) a[kk] = *(const LAS bf16x8*)(Kt + (d0 + l15) * 72 + 8 * lq + 32 * kk);
#pragma unroll
                for (int et = 0; et < 8; ++et) { f32x4 acc = {0.f, 0.f, 0.f, 0.f};
#pragma unroll
                    for (int kk = 0; kk < 2; ++kk) { const bf16x8 bf = *(const LAS bf16x8*)(Vt + (16 * et + l15) * 72 + 8 * lq + 32 * kk); acc = __builtin_amdgcn_mfma_f32_16x16x32_bf16(a[kk], bf, acc, 0, 0, 0); }
                    u32x2 w2; w2.x = cvt_pk_bf16(acc[0], acc[1]); w2.y = cvt_pk_bf16(acc[2], acc[3]);
                    *(u32x2*)(Ut + (size_t)unit * (HD * HD) + (16 * et + l15) * HD + d0 + 4 * lq) = w2; }
                __syncthreads();
            }
        }
    }
    SEAM(2);

    if (IN(3)) {
        for (int idx = blockIdx.x * NTHR + tid; idx < BATCH * NH * HD * (HD / 4); idx += G * NTHR) {
            const int bh = idx >> 12, el = idx & 4095, d4 = el & 31;
            float S0 = 0.f, S1 = 0.f, S2 = 0.f, S3 = 0.f;
            bf16_t* up = Ut + (size_t)bh * NCHUNK * (HD * HD) + (size_t)el * 4; const float* dp = dec + (size_t)bh * NCHUNK * HD + d4 * 4;
#pragma unroll 8
            for (int c = 0; c < NCHUNK; ++c) { const u32x2 uv = *(const u32x2*)(up + (size_t)c * (HD * HD)); const f32x4 dv = *(const f32x4*)(dp + c * HD);
                u32x2 sv; sv.x = cvt_pk_bf16(S0, S1); sv.y = cvt_pk_bf16(S2, S3); *(u32x2*)(up + (size_t)c * (HD * HD)) = sv;
                S0 = dv[0] * (S0 + bflo(uv.x)); S1 = dv[1] * (S1 + bfhi(uv.x)); S2 = dv[2] * (S2 + bflo(uv.y)); S3 = dv[3] * (S3 + bfhi(uv.y)); }
        }
    }
    SEAM(3);

    if (IN(4)) {
        LAS bf16_t* Qs = (LAS bf16_t*)(lds);
        LAS bf16_t* Ks = (LAS bf16_t*)(lds + 17408);
        LAS bf16_t* Vt = (LAS bf16_t*)(lds + 34816);
        LAS bf16_t* St = (LAS bf16_t*)(lds + 53248);
        LAS bf16_t* As = (LAS bf16_t*)(lds + 88064);
        LAS float* PT = (LAS float*)(lds + 97280);
        LAS float* SS = (LAS float*)(lds + 99328);
        const float* recg = args.in[9];
        const int d = tid & 127, part = tid >> 7, l15 = lane & 15, lq = lane >> 4;
        for (int unit = blockIdx.x; unit < NUNIT; unit += G) {
            const int c = unit & 63, bh = unit >> 6, h = bh & 3, b = bh >> 2; const size_t r0 = (size_t)b * SEQ + 64 * c;
            float lf[16]; float qv[16];
#pragma unroll
            for (int i = 0; i < 16; ++i) { lf[i] = logf[(r0 + 16 * part + i) * DR + h * HD + d]; qv[i] = __uint_as_float((unsigned)qb[(r0 + 16 * part + i) * DR + h * HD + d] << 16); }
            u32x4 vv[2];
#pragma unroll
            for (int it = 0; it < 2; ++it) { const int idx = tid + 512 * it, s = idx >> 4, e8 = idx & 15; vv[it] = *(const u32x4*)(vb + (r0 + s) * DR + h * HD + e8 * 8); }
#pragma unroll
            for (int it = 0; it < 4; ++it) { const int idx = tid + 512 * it, e = idx >> 4, d8 = idx & 15;
                *(LAS u32x4*)(St + e * 136 + d8 * 8) = *(const u32x4*)(Ut + (size_t)unit * (HD * HD) + e * HD + d8 * 8); }
            float bc[16]; float run = 0.f;
#pragma unroll
            for (int i = 0; i < 16; ++i) { run += lf[i]; bc[i] = run; }
            PT[part * 128 + d] = run;
#pragma unroll
            for (int it = 0; it < 2; ++it) { const int idx = tid + 512 * it, s = idx >> 4, e8 = idx & 15;
#pragma unroll
                for (int j = 0; j < 4; ++j) { const unsigned w = vv[it][j]; Vt[(e8 * 8 + 2 * j) * 72 + s] = (bf16_t)(w & 0xffffu); Vt[(e8 * 8 + 2 * j + 1) * 72 + s] = (bf16_t)(w >> 16); } }
            __syncthreads();
            float off = 0.f;
#pragma unroll
            for (int p = 0; p < 3; ++p) off += (p < part) ? PT[p * 128 + d] : 0.f;
#pragma unroll
            for (int i = 0; i < 16; ++i) { const float bb = bc[i] + off; const float qt = qv[i] * __expf(bb), kt = (1.0f - __expf(lf[i])) * __expf(-bb);
                Qs[(16 * part + i) * 136 + d] = (bf16_t)(cvt_pk_bf16(qt, 0.f) & 0xffffu); Ks[(16 * part + i) * 136 + d] = (bf16_t)(cvt_pk_bf16(kt, 0.f) & 0xffffu); }
            __syncthreads();
            {
                const int tt = wave >> 1;
#pragma unroll
                for (int sti = 0; sti < 2; ++sti) { const int st = 2 * (wave & 1) + sti; f32x4 acc = {0.f, 0.f, 0.f, 0.f};
                    if (st <= tt) {
#pragma unroll
                        for (int kk = 0; kk < 4; ++kk) { const bf16x8 ak = *(const LAS bf16x8*)(Ks + (16 * st + l15) * 136 + 8 * lq + 32 * kk); const bf16x8 bq = *(const LAS bf16x8*)(Qs + (16 * tt + l15) * 136 + 8 * lq + 32 * kk);
                            acc = __builtin_amdgcn_mfma_f32_16x16x32_bf16(ak, bq, acc, 0, 0, 0); } }
                    const int t = 16 * tt + l15, s0 = 16 * st + 4 * lq;
#pragma unroll
                    for (int r = 0; r < 4; ++r) if (s0 + r > t) acc[r] = 0.f;
                    u32x2 w2; w2.x = cvt_pk_bf16(acc[0], acc[1]); w2.y = cvt_pk_bf16(acc[2], acc[3]);
                    *(LAS u32x2*)(As + t * 72 + s0) = w2; }
            }
            __syncthreads();
            {
                const int tt = wave & 3, eh = wave >> 2, t = 16 * tt + l15;
                bf16x8 bA[2], bQ[4];
#pragma unroll
                for (int kk = 0; kk < 2; ++kk) bA[kk] = *(const LAS bf16x8*)(As + t * 72 + 8 * lq + 32 * kk);
#pragma unroll
                for (int kk = 0; kk < 4; ++kk) bQ[kk] = *(const LAS bf16x8*)(Qs + t * 136 + 8 * lq + 32 * kk);
                f32x4 o[4]; u32x2 gv[4]; float ss = 0.f;
#pragma unroll
                for (int et = 0; et < 4; ++et) { const int e0 = 16 * (4 * eh + et);
                    gv[et] = *(const u32x2*)(gs + (r0 + t) * DR + h * HD + e0 + 4 * lq);
                    f32x4 acc = {0.f, 0.f, 0.f, 0.f};
#pragma unroll
                    for (int kk = 0; kk < 2; ++kk) { const bf16x8 av = *(const LAS bf16x8*)(Vt + (e0 + l15) * 72 + 8 * lq + 32 * kk); acc = __builtin_amdgcn_mfma_f32_16x16x32_bf16(av, bA[kk], acc, 0, 0, 0); }
#pragma unroll
                    for (int kk = 0; kk < 4; ++kk) { const bf16x8 as = *(const LAS bf16x8*)(St + (e0 + l15) * 136 + 8 * lq + 32 * kk); acc = __builtin_amdgcn_mfma_f32_16x16x32_bf16(as, bQ[kk], acc, 0, 0, 0); }
                    o[et] = acc; ss += (acc[0] * acc[0] + acc[1] * acc[1]) + (acc[2] * acc[2] + acc[3] * acc[3]); }
                ss += __shfl_xor(ss, 16); ss += __shfl_xor(ss, 32);
                if (lq == 0) SS[t * 2 + eh] = ss;
                __syncthreads();
                const float rs = __builtin_amdgcn_rsqf((SS[t * 2] + SS[t * 2 + 1]) * (1.0f / HD) + EPS);
#pragma unroll
                for (int et = 0; et < 4; ++et) { const int e = 16 * (4 * eh + et) + 4 * lq; const f32x4 rg = *(const f32x4*)(recg + h * HD + e);
                    const float y0 = o[et][0] * rs * rg[0] * bflo(gv[et].x), y1 = o[et][1] * rs * rg[1] * bfhi(gv[et].x), y2 = o[et][2] * rs * rg[2] * bflo(gv[et].y), y3 = o[et][3] * rs * rg[3] * bfhi(gv[et].y);
                    u32x2 w2; w2.x = cvt_pk_bf16(y0, y1); w2.y = cvt_pk_bf16(y2, y3);
                    *(u32x2*)(yb + (r0 + t) * D + DC + h * HD + e) = w2; }
            }
            __syncthreads();
        }
    }
    SEAM(4);

    if (IN(5)) { pg8::Gemm g{yb, WoutT, M, D, D}; pg8::StaticOrder S; S.init(M, D, G, (int)blockIdx.x);
        pg8::EpiOut E{xin, outp, xb, ssq2};
        pg8::gemm_phase<pg8::EpiOut, pg8::StaticOrder, true, true>(lds, g, S, E); }
    SEAM(5);
    if (IN(6)) { pg8::Gemm g{xb, WupT, M, FF, D}; pg8::StaticOrder S; S.init(M, FF, G, (int)blockIdx.x);
        pg8::EpiUp E{tb};
        pg8::gemm_phase<pg8::EpiUp, pg8::StaticOrder, true, true>(lds, g, S, E); }
    SEAM(6);
    if (IN(7)) { pg8::Gemm g{tb, WdownT, M, D, FF}; pg8::StaticOrder S; S.init(M, D, G, (int)blockIdx.x);
        pg8::EpiDown E{ssq2, outp, xb};
        pg8::gemm_phase<pg8::EpiDown, pg8::StaticOrder, true, true>(lds, g, S, E); }
    SEAM(7);
    if (IN(8)) { pg8::Gemm g{xb, WgateT, M, D, D}; pg8::StaticOrder S; S.init(M, D, G, (int)blockIdx.x);
        pg8::EpiGate E{outp, eb, ssqE, args.in[15], ssq3};
        pg8::gemm_phase<pg8::EpiGate, pg8::StaticOrder, true, true>(lds, g, S, E); }
    SEAM(8);
    if (IN(9)) {
        const f32x4* gf = (const f32x4*)args.in[17] + lane; f32x4 gfv[4];
#pragma unroll
        for (int j = 0; j < 4; ++j) gfv[j] = gf[64 * j];
        for (int m = gw; m < M; m += NGW) { const float rs = __builtin_amdgcn_rsqf(ssq3[m] * (1.0f / D) + EPS);
            f32x4* orow = (f32x4*)(outp + (size_t)m * D) + lane;
#pragma unroll
            for (int j = 0; j < 4; ++j) orow[64 * j] = orow[64 * j] * rs * gfv[j]; }
    }
#undef IN
#undef SEAM
}

#ifndef DBG_STOP
#define DBG_STOP -1
#endif
#ifndef DBG_OFF
#define DBG_OFF (WS_LOGF + 32 * MiB)
#endif
__global__ void dbg_dump(const unsigned short* src, float* o, int n) { for (int i = blockIdx.x * blockDim.x + threadIdx.x; i < n; i += gridDim.x * blockDim.x) o[i] = (float)src[i]; }
extern "C" void kernel_launch(void* const* d_in, const int* in_sizes, int n_in, void* d_out, int out_size, void* d_ws, size_t ws_size, hipStream_t stream) {
    static int grid = 0;
    if (grid == 0) {
        if (n_in != 18 || in_sizes[0] != M * D || out_size != M * D || ws_size < WS_END) { fprintf(stderr, "kernel_launch: unexpected shapes (n_in %d, in0 %d, out %d, ws %zu)\n", n_in, n_in > 0 ? in_sizes[0] : -1, out_size, ws_size); grid = -1; return; }
        int dev = 0, cus = 0, per_cu = 0;
        hipGetDevice(&dev); hipDeviceGetAttribute(&cus, hipDeviceAttributeMultiprocessorCount, dev);
        if (hipFuncSetAttribute((const void*)mk_fwd, hipFuncAttributeMaxDynamicSharedMemorySize, LDS_BYTES) != hipSuccess) { fprintf(stderr, "kernel_launch: hipFuncSetAttribute failed\n"); grid = -1; return; }
        if (hipOccupancyMaxActiveBlocksPerMultiprocessor(&per_cu, (const void*)mk_fwd, NTHR, LDS_BYTES) != hipSuccess || per_cu < 1) { fprintf(stderr, "kernel_launch: occupancy query says %d\n", per_cu); per_cu = 1; }
        (void)hipGetLastError();
        grid = cus;
    }
    if (grid < 0) return;
    Args a{};
    for (int i = 0; i < 18; ++i) a.in[i] = (const float*)d_in[i];
    a.out = (float*)d_out; a.ws = (unsigned char*)d_ws;
#if MK_COOP
    a.ph_lo = 0; a.ph_hi = N_PHASES;
    void* kargs[] = {&a};
    hipError_t e = hipLaunchCooperativeKernel((const void*)mk_fwd, dim3(grid), dim3(NTHR), kargs, LDS_BYTES, stream);
    if (e != hipSuccess) fprintf(stderr, "cooperative launch failed: %s (grid %d)\n", hipGetErrorString(e), grid);
#else
    for (int p = 0; p < N_PHASES; ++p) { if (DBG_STOP >= 0 && p > DBG_STOP) break; a.ph_lo = p; a.ph_hi = p + 1; hipLaunchKernelGGL(mk_fwd, dim3(grid), dim3(NTHR), LDS_BYTES, stream, a); }
    if (DBG_STOP >= 0) hipLaunchKernelGGL(dbg_dump, dim3(2048), dim3(256), 0, stream, (const unsigned short*)((unsigned char*)d_ws + DBG_OFF), (float*)d_out, M * D);
#endif
}
```

```cpp
#include <hip/hip_runtime.h>
#include <hip/hip_cooperative_groups.h>
#include <cstdio>
#include <cstdint>
namespace cg = cooperative_groups;
namespace pg8 {
#define PG8_LAS __attribute__((address_space(3)))
typedef unsigned short bf16_t;
typedef short bf16x8 __attribute__((ext_vector_type(8)));
typedef float f32x4 __attribute__((ext_vector_type(4)));
typedef unsigned u32x4 __attribute__((ext_vector_type(4)));
constexpr int BM = 256, BK = 64, HALF = 128, HTB = HALF * BK * 2  , STAGE_BYTES = 8 * HTB, NXCD = 8, WGM = 8;

__host__ __device__ __forceinline__ int lds_byte(int r, int c) { const int st = (r >> 4) * 2 + (c >> 5), rr = r & 15, cc = c & 31, ob = rr * 64 + cc * 2; return st * 1024 + (ob ^ (((ob >> 9) & 1) << 5)); }
__host__ __device__ __forceinline__ void stage_rc(int b, int& R, int& C) { const int st = b / 1024, sb = b % 1024, swz = sb ^ (((sb >> 9) & 1) << 5); R = (st >> 1) * 16 + swz / 64; C = (st & 1) * 32 + (swz % 64) / 2; }
__host__ __device__ __forceinline__ int perm32(int rho) { const int n = rho >> 4, i = rho & 15; return 8 * (i >> 2) + 4 * n + (i & 3); }

struct Unit { int pm, pn; };
struct Gemm { const bf16_t* A; const bf16_t* Bt; int M, N, K; };

struct StaticOrder {
    int nM, nN, nwg, G, c;
    __host__ __device__ void init(int M, int N, int G_, int c_) { nM = M / BM; nN = N / BM; nwg = nM * nN; G = G_; c = c_; }
    __host__ __device__ bool next(int i, Unit& u) const {
        const long L = (long)i * G + c; if (L >= nwg) return false;
        int wgid = (int)L; { const int q = nwg / NXCD, r = nwg % NXCD, xcd = wgid % NXCD, off = wgid / NXCD; wgid = (xcd < r ? xcd * (q + 1) : r * (q + 1) + (xcd - r) * q) + off; }
        const int nig = WGM * nN, gid = wgid / nig, fm = gid * WGM, gsz = (nM - fm) < WGM ? (nM - fm) : WGM;
        u.pm = fm + ((wgid % nig) % gsz); u.pn = (wgid % nig) / gsz; return true;
    }
    __device__ __forceinline__ void a_ready(const Unit&) const {}
    __device__ __forceinline__ void done(const Unit&) const {}
};

typedef __bf16 bf16x2_t __attribute__((ext_vector_type(2)));
typedef float f32x2_t __attribute__((ext_vector_type(2)));
__device__ __forceinline__ unsigned cvt_pk_bf16(float lo, float hi) { const f32x2_t v = {lo, hi}; const bf16x2_t b = __builtin_convertvector(v, bf16x2_t); return __builtin_bit_cast(unsigned, b); }
typedef float f32x2 __attribute__((ext_vector_type(2)));
typedef unsigned u32x2 __attribute__((ext_vector_type(2)));
__device__ __forceinline__ float sigm(float x) { return __builtin_amdgcn_rcpf(1.0f + __expf(-x)); }
__device__ __forceinline__ unsigned cvt_pk_bf16_asm(float lo, float hi) { unsigned r; asm volatile("v_cvt_pk_bf16_f32 %0, %1, %2" : "=v"(r) : "v"(lo), "v"(hi)); return r; }
__device__ __forceinline__ u32x4 pack8(const f32x4& a, const f32x4& b) { u32x4 w; w.x = cvt_pk_bf16_asm(a[0], a[1]); w.y = cvt_pk_bf16_asm(a[2], a[3]); w.z = cvt_pk_bf16_asm(b[0], b[1]); w.w = cvt_pk_bf16_asm(b[2], b[3]); return w; }
__device__ __forceinline__ u32x4 pack8v(const f32x4& a, const f32x4& b) { u32x4 w; w.x = cvt_pk_bf16(a[0], a[1]); w.y = cvt_pk_bf16(a[2], a[3]); w.z = cvt_pk_bf16(b[0], b[1]); w.w = cvt_pk_bf16(b[2], b[3]); return w; }
__device__ __forceinline__ float bflo(unsigned w) { return __uint_as_float(w << 16); }
__device__ __forceinline__ float bfhi(unsigned w) { return __uint_as_float(w & 0xffff0000u); }
constexpr float EPS_ = 1e-6f;

struct EpiIn {
    static constexpr bool PERM = true, AFTER_DRAIN = false;
    const float* rstd1; const float* lbl; bf16_t* cglu; bf16_t* qb; bf16_t* gs; _Float16* logf; bf16_t* vb;
    __device__ __forceinline__ void operator()(const f32x4 (&acc)[2][2][4][2], const Unit& u, int wr, int wc, int fr, int fq) const {
        asm volatile("s_nop 15\n\ts_nop 15" ::: "memory");
        const int kind = u.pn >> 2, j = u.pn & 3;
        const int col = j * 128 + wc * 32 + 8 * fq;
        const int row0 = u.pm * BM + wr * 64 + fr;
        if (kind == 0) {
#pragma unroll
            for (int ai = 0; ai < 2; ++ai)
#pragma unroll
                for (int m = 0; m < 4; ++m) { const int row = row0 + ai * HALF + m * 16;
                    f32x4 a0 = acc[ai][0][m][0], a1 = acc[ai][0][m][1], b0 = acc[ai][1][m][0], b1 = acc[ai][1][m][1];
#pragma unroll
                    for (int e = 0; e < 4; ++e) { a0[e] *= sigm(b0[e]); a1[e] *= sigm(b1[e]); }
                    *(u32x4*)(cglu + (size_t)row * 512 + col) = pack8(a0, a1); }
        } else if (kind == 1) {
#pragma unroll
            for (int ai = 0; ai < 2; ++ai)
#pragma unroll
                for (int m = 0; m < 4; ++m) { const int row = row0 + ai * HALF + m * 16;
                    f32x4 a0 = acc[ai][0][m][0], a1 = acc[ai][0][m][1], b0 = acc[ai][1][m][0], b1 = acc[ai][1][m][1];
#pragma unroll
                    for (int e = 0; e < 4; ++e) { b0[e] *= sigm(b0[e]); b1[e] *= sigm(b1[e]); }
                    __builtin_nontemporal_store(pack8(a0, a1), (u32x4*)(qb + (size_t)row * 512 + col));
                    __builtin_nontemporal_store(pack8(b0, b1), (u32x4*)(gs + (size_t)row * 512 + col)); }
        } else {
            float lb[8];
#pragma unroll
            for (int e = 0; e < 8; ++e) lb[e] = __builtin_amdgcn_rcpf(1.0f + __expf(lbl[512 + col + e] - lbl[col + e]));
#pragma unroll
            for (int ai = 0; ai < 2; ++ai)
#pragma unroll
                for (int m = 0; m < 4; ++m) { const int row = row0 + ai * HALF + m * 16;
                    f32x4 a0 = acc[ai][0][m][0], a1 = acc[ai][0][m][1], b0 = acc[ai][1][m][0], b1 = acc[ai][1][m][1];
#pragma unroll
                    for (int e = 0; e < 4; ++e) { a0[e] = 0.69314718056f * __builtin_amdgcn_logf(lb[e] + (1.0f - lb[e]) * sigm(a0[e])); a1[e] = 0.69314718056f * __builtin_amdgcn_logf(lb[4 + e] + (1.0f - lb[4 + e]) * sigm(a1[e])); }
                    { typedef _Float16 h2_t __attribute__((ext_vector_type(2))); u32x4 w;
                      w.x = __builtin_bit_cast(unsigned, __builtin_convertvector((f32x2_t){a0[0], a0[1]}, h2_t)); w.y = __builtin_bit_cast(unsigned, __builtin_convertvector((f32x2_t){a0[2], a0[3]}, h2_t));
                      w.z = __builtin_bit_cast(unsigned, __builtin_convertvector((f32x2_t){a1[0], a1[1]}, h2_t)); w.w = __builtin_bit_cast(unsigned, __builtin_convertvector((f32x2_t){a1[2], a1[3]}, h2_t));
                      *(u32x4*)(logf + (size_t)row * 512 + col) = w; }
                    *(u32x4*)(vb + (size_t)row * 512 + col) = pack8(b0, b1); }
        }
    }
};
struct EpiPle {
    static constexpr bool PERM = true, AFTER_DRAIN = false;
    bf16_t* e; float* ssq;
    __device__ __forceinline__ void operator()(const f32x4 (&acc)[2][2][4][2], const Unit& u, int wr, int wc, int fr, int fq) const {
        asm volatile("s_nop 15\n\ts_nop 15" ::: "memory");
        const int row0 = u.pm * BM + wr * 64 + fr, col0 = u.pn * BM + wc * 32 + 8 * fq;
#pragma unroll
        for (int ai = 0; ai < 2; ++ai)
#pragma unroll
            for (int m = 0; m < 4; ++m) { const int row = row0 + ai * HALF + m * 16; float ss = 0.f;
#pragma unroll
                for (int bj = 0; bj < 2; ++bj) { const f32x4 a0 = acc[ai][bj][m][0], a1 = acc[ai][bj][m][1];
                    __builtin_nontemporal_store(pack8(a0, a1), (u32x4*)(e + (size_t)row * 1024 + col0 + bj * HALF));
                    ss += (a0[0] * a0[0] + a0[1] * a0[1]) + (a0[2] * a0[2] + a0[3] * a0[3]) + (a1[0] * a1[0] + a1[1] * a1[1]) + (a1[2] * a1[2] + a1[3] * a1[3]); }
                ss += __shfl_xor(ss, 16); ss += __shfl_xor(ss, 32);
                if (fq == 0) __hip_atomic_fetch_add(ssq + row, ss, __ATOMIC_RELAXED, __HIP_MEMORY_SCOPE_AGENT); }
    }
};
struct EpiOut {
    static constexpr bool PERM = true, AFTER_DRAIN = false;
    bf16_t* hb; float* ssq; const float* inv1;
    __device__ __forceinline__ void operator()(const f32x4 (&acc)[2][2][4][2], const Unit& u, int wr, int wc, int fr, int fq) const {
        asm volatile("s_nop 15\n\ts_nop 15" ::: "memory");
        const int row0 = u.pm * BM + wr * 64 + fr, col0 = u.pn * BM + wc * 32 + 8 * fq;
        float iv[8];
#pragma unroll
        for (int g = 0; g < 8; ++g) iv[g] = inv1[row0 + (g >> 2) * HALF + (g & 3) * 16];
        u32x4 hq[8][2];
#define EPI_H(g_) do { _Pragma("unroll") for (int bj = 0; bj < 2; ++bj) hq[g_][bj] = *(const u32x4*)(hb + (size_t)(row0 + ((g_) >> 2) * HALF + ((g_) & 3) * 16) * 1024 + col0 + bj * HALF); } while (0)
        EPI_H(0); EPI_H(1); EPI_H(2); EPI_H(3);
        asm volatile("" ::: "memory");
#pragma unroll
        for (int g = 0; g < 8; ++g) { const int ai = g >> 2, m = g & 3; const int row = row0 + ai * HALF + m * 16; float ss = 0.f;
            if (g + 4 < 8) EPI_H(g + 4);
#pragma unroll
            for (int bj = 0; bj < 2; ++bj) { const size_t off = (size_t)row * 1024 + col0 + bj * HALF;
                const u32x4 hv = hq[g][bj];
                const f32x4 h0 = {bflo(hv.x), bfhi(hv.x), bflo(hv.y), bfhi(hv.y)}, h1 = {bflo(hv.z), bfhi(hv.z), bflo(hv.w), bfhi(hv.w)};
                const f32x4 a0 = h0 * iv[g] + acc[ai][bj][m][0], a1 = h1 * iv[g] + acc[ai][bj][m][1];
                *(u32x4*)(hb + off) = pack8(a0, a1);
                ss += (a0[0] * a0[0] + a0[1] * a0[1]) + (a0[2] * a0[2] + a0[3] * a0[3]) + (a1[0] * a1[0] + a1[1] * a1[1]) + (a1[2] * a1[2] + a1[3] * a1[3]); }
            ss += __shfl_xor(ss, 16); ss += __shfl_xor(ss, 32);
            if (fq == 0) __hip_atomic_fetch_add(ssq + row, ss, __ATOMIC_RELAXED, __HIP_MEMORY_SCOPE_AGENT);
            asm volatile("" ::: "memory"); }
#undef EPI_H
    }
};
struct EpiUp {
    static constexpr bool PERM = true, AFTER_DRAIN = false;
    bf16_t* t;
    __device__ __forceinline__ void operator()(const f32x4 (&acc)[2][2][4][2], const Unit& u, int wr, int wc, int fr, int fq) const {
        asm volatile("s_nop 15\n\ts_nop 15" ::: "memory");
        const int row0 = u.pm * BM + wr * 64 + fr, col0 = u.pn * BM + wc * 32 + 8 * fq;
#pragma unroll
        for (int ai = 0; ai < 2; ++ai)
#pragma unroll
            for (int m = 0; m < 4; ++m) { const int row = row0 + ai * HALF + m * 16;
#pragma unroll
                for (int bj = 0; bj < 2; ++bj) { f32x4 a0 = acc[ai][bj][m][0], a1 = acc[ai][bj][m][1];
#pragma unroll
                    for (int e = 0; e < 4; ++e) { const float p = fmaxf(a0[e], 0.f), q = fmaxf(a1[e], 0.f); a0[e] = p * p; a1[e] = q * q; }
                    *(u32x4*)(t + (size_t)row * 4096 + col0 + bj * HALF) = pack8(a0, a1); } }
    }
};
struct EpiDown {
    static constexpr bool PERM = true, AFTER_DRAIN = false;
    const float* ssq2; bf16_t* hb;
    __device__ __forceinline__ void operator()(const f32x4 (&acc)[2][2][4][2], const Unit& u, int wr, int wc, int fr, int fq) const {
        asm volatile("s_nop 15\n\ts_nop 15" ::: "memory");
        const int row0 = u.pm * BM + wr * 64 + fr, col0 = u.pn * BM + wc * 32 + 8 * fq;
        u32x4 hq[8][2]; float sq[8];
#pragma unroll
        for (int g = 0; g < 8; ++g) sq[g] = ssq2[row0 + (g >> 2) * HALF + (g & 3) * 16];
#define EPI_H(g_) do { _Pragma("unroll") for (int bj = 0; bj < 2; ++bj) hq[g_][bj] = *(const u32x4*)(hb + (size_t)(row0 + ((g_) >> 2) * HALF + ((g_) & 3) * 16) * 1024 + col0 + bj * HALF); } while (0)
        EPI_H(0); EPI_H(1); EPI_H(2); EPI_H(3);
        asm volatile("" ::: "memory");
#pragma unroll
        for (int g = 0; g < 8; ++g) { const int ai = g >> 2, m = g & 3; const int row = row0 + ai * HALF + m * 16; const float r2 = __builtin_amdgcn_rcpf(sq[g] * (1.0f / 1024.0f) + EPS_);
            if (g + 4 < 8) EPI_H(g + 4);
#pragma unroll
            for (int bj = 0; bj < 2; ++bj) { const size_t off = (size_t)row * 1024 + col0 + bj * HALF;
                const u32x4 hv = hq[g][bj];
                const f32x4 h0 = {bflo(hv.x), bfhi(hv.x), bflo(hv.y), bfhi(hv.y)}, h1 = {bflo(hv.z), bfhi(hv.z), bflo(hv.w), bfhi(hv.w)};
                const f32x4 a0 = h0 + acc[ai][bj][m][0] * r2, a1 = h1 + acc[ai][bj][m][1] * r2;
                *(u32x4*)(hb + off) = pack8(a0, a1); }
            asm volatile("" ::: "memory"); }
#undef EPI_H
    }
};
struct EpiGateFinal {
    static constexpr bool PERM = true, AFTER_DRAIN = false;
    float* out; const bf16_t* hb; const bf16_t* e; const float* ssqE; const float* gple; float* ssq3; unsigned* cnt; const float* gfin;
    __device__ __forceinline__ void operator()(f32x4 (&acc)[2][2][4][2], const Unit& u, int wr, int wc, int fr, int fq) const {
        asm volatile("s_nop 15\n\ts_nop 15" ::: "memory");
        const int row0 = u.pm * BM + wr * 64 + fr, col0 = u.pn * BM + wc * 32 + 8 * fq;
        {
        u32x4 hq[8][2], eq[8][2]; float sq[8];
#define EGF_E(g_) do { _Pragma("unroll") for (int bj = 0; bj < 2; ++bj) eq[g_][bj] = __builtin_nontemporal_load((const u32x4*)(e + (size_t)(row0 + ((g_) >> 2) * HALF + ((g_) & 3) * 16) * 1024 + col0 + bj * HALF)); } while (0)
#pragma unroll
        for (int g = 0; g < 8; ++g) sq[g] = ssqE[row0 + (g >> 2) * HALF + (g & 3) * 16];
#define EGF_H(g_) do { _Pragma("unroll") for (int bj = 0; bj < 2; ++bj) hq[g_][bj] = *(const u32x4*)(hb + (size_t)(row0 + ((g_) >> 2) * HALF + ((g_) & 3) * 16) * 1024 + col0 + bj * HALF); } while (0)
        EGF_H(0); EGF_E(0); EGF_H(1); EGF_E(1);
        f32x4 gp[2][2];
#pragma unroll
        for (int bj = 0; bj < 2; ++bj) { gp[bj][0] = *(const f32x4*)(gple + col0 + bj * HALF); gp[bj][1] = *(const f32x4*)(gple + col0 + bj * HALF + 4); }
        asm volatile("" ::: "memory");
#pragma unroll
        for (int g = 0; g < 8; ++g) { const int ai = g >> 2, m = g & 3; const int row = row0 + ai * HALF + m * 16; const float rE = __builtin_amdgcn_rsqf(sq[g] * (1.0f / 1024.0f) + EPS_); float ss = 0.f;
            if (g + 2 < 8) { EGF_H(g + 2); EGF_E(g + 2); }
#pragma unroll
            for (int bj = 0; bj < 2; ++bj) {
                const u32x4 ev = eq[g][bj];
                f32x4 e0 = {bflo(ev.x), bfhi(ev.x), bflo(ev.y), bfhi(ev.y)}, e1 = {bflo(ev.z), bfhi(ev.z), bflo(ev.w), bfhi(ev.w)};
                f32x4 s0 = acc[ai][bj][m][0], s1 = acc[ai][bj][m][1];
#pragma unroll
                for (int k = 0; k < 4; ++k) { s0[k] = sigm(s0[k]); s1[k] = sigm(s1[k]); }
                const u32x4 hv = hq[g][bj];
                const f32x4 h0 = {bflo(hv.x), bfhi(hv.x), bflo(hv.y), bfhi(hv.y)}, h1 = {bflo(hv.z), bfhi(hv.z), bflo(hv.w), bfhi(hv.w)};
                const f32x4 a0 = h0 + e0 * rE * gp[bj][0] * s0, a1 = h1 + e1 * rE * gp[bj][1] * s1;
                acc[ai][bj][m][0] = a0; acc[ai][bj][m][1] = a1;
                ss += (a0[0] * a0[0] + a0[1] * a0[1]) + (a0[2] * a0[2] + a0[3] * a0[3]) + (a1[0] * a1[0] + a1[1] * a1[1]) + (a1[2] * a1[2] + a1[3] * a1[3]); }
            ss += __shfl_xor(ss, 16); ss += __shfl_xor(ss, 32);
            if (fq == 0) __hip_atomic_fetch_add(ssq3 + row, ss, __ATOMIC_RELAXED, __HIP_MEMORY_SCOPE_AGENT);
            asm volatile("" ::: "memory"); }
#undef EGF_E
#undef EGF_H
        }
        asm volatile("s_waitcnt vmcnt(0)" ::: "memory");
        unsigned* pc = cnt + 64 * u.pm;
        if ((threadIdx.x & 63) == 0) __hip_atomic_fetch_add(pc, 1u, __ATOMIC_RELAXED, __HIP_MEMORY_SCOPE_AGENT);
        { unsigned sp = 0;
          while ((unsigned)__builtin_amdgcn_readfirstlane(__hip_atomic_load(pc, __ATOMIC_RELAXED, __HIP_MEMORY_SCOPE_AGENT)) < 32u) { __builtin_amdgcn_s_sleep(2); if (++sp > (1u << 22)) break; } }
        __builtin_amdgcn_fence(__ATOMIC_ACQUIRE, "agent");
        float s3[8];
#pragma unroll
        for (int g = 0; g < 8; ++g) s3[g] = __hip_atomic_load(ssq3 + row0 + (g >> 2) * HALF + (g & 3) * 16, __ATOMIC_RELAXED, __HIP_MEMORY_SCOPE_AGENT);
        f32x4 gf[2][2];
#pragma unroll
        for (int bj = 0; bj < 2; ++bj) { gf[bj][0] = *(const f32x4*)(gfin + col0 + bj * HALF); gf[bj][1] = *(const f32x4*)(gfin + col0 + bj * HALF + 4); }
#pragma unroll
        for (int ai = 0; ai < 2; ++ai)
#pragma unroll
            for (int m = 0; m < 4; ++m) { const int row = row0 + ai * HALF + m * 16;
                const float rs = __builtin_amdgcn_rsqf(s3[ai * 4 + m] * (1.0f / 1024.0f) + EPS_);
#pragma unroll
                for (int bj = 0; bj < 2; ++bj) { const size_t off = (size_t)row * 1024 + col0 + bj * HALF;
                    *(f32x4*)(out + off) = acc[ai][bj][m][0] * rs * gf[bj][0]; *(f32x4*)(out + off + 4) = acc[ai][bj][m][1] * rs * gf[bj][1]; }
                asm volatile("" ::: "memory"); }
    }
};

template <class Epi, class Sched, bool ALIGN_EPI = false, bool SP2 = false>
__device__ __forceinline__ void gemm_phase(PG8_LAS unsigned char* lds, const Gemm g, const Sched& S, const Epi& E) {
    const int tid = threadIdx.x, wid = __builtin_amdgcn_readfirstlane(tid >> 6), lane = tid & 63, wr = wid >> 2, wc = wid & 3, fr = lane & 15, fq = lane >> 4;
    const int K = g.K, nt = K / BK;
    unsigned voffA[2], voffB[2];
#pragma unroll
    for (int i = 0; i < 2; ++i) { int R, C; stage_rc(tid * 16 + i * 8192, R, C); const int Rb = Epi::PERM ? ((R & ~31) + perm32(R & 31)) : R;
        voffA[i] = (unsigned)(R * K + C) * 2u; voffB[i] = (unsigned)(Rb * K + C) * 2u; }
    const size_t kstep = (size_t)(BK * 2);
    const size_t hstep = (size_t)HALF * K * 2;
    const size_t tstep = 2 * hstep;
    const unsigned ldsw = (unsigned)wid * 1024u;
    const int aoff = lds_byte(wr * 64 + fr, fq * 8), boff = lds_byte(wc * 32 + fr, fq * 8);
#define PG8_SA(b, h) (((b) * 2 + (h)) * HTB)
#define PG8_SB(b, h) ((4 + (b) * 2 + (h)) * HTB)
#define PG8_STAGE(bufoff, gbase, voff) do { _Pragma("unroll") for (int _i = 0; _i < 2; ++_i) \
        __builtin_amdgcn_global_load_lds((const unsigned*)((const char*)(gbase) + (voff)[_i]), (PG8_LAS unsigned*)(lds + (bufoff) + ldsw + _i * 8192), 16, 0, 0); } while (0)
#define PG8_LDA(dst, b, h) do { _Pragma("unroll") for (int m = 0; m < 4; ++m) _Pragma("unroll") for (int k = 0; k < 2; ++k) dst[m][k] = *(const PG8_LAS bf16x8*)(lds + PG8_SA(b, h) + aoff + m * 2048 + k * 1024); } while (0)
#define PG8_LDB(dst, b, h) do { _Pragma("unroll") for (int n = 0; n < 2; ++n) _Pragma("unroll") for (int k = 0; k < 2; ++k) dst[n][k] = *(const PG8_LAS bf16x8*)(lds + PG8_SB(b, h) + boff + n * 2048 + k * 1024); } while (0)
#define PG8_MMA(ai, bj, At, Bt) do { __builtin_amdgcn_s_setprio(1); _Pragma("unroll") for (int m = 0; m < 4; ++m) _Pragma("unroll") for (int n = 0; n < 2; ++n) _Pragma("unroll") for (int k = 0; k < 2; ++k) \
        acc[ai][bj][m][n] = __builtin_amdgcn_mfma_f32_16x16x32_bf16(Bt[n][k], At[m][k], acc[ai][bj][m][n], 0, 0, 0); __builtin_amdgcn_s_setprio(0); } while (0)
#define PG8_WAIT_V(n) asm volatile("s_waitcnt vmcnt(" #n ")" ::: "memory")
#define PG8_WAIT_L(n) asm volatile("s_waitcnt lgkmcnt(" #n ")" ::: "memory")
#define PG8_BAR __builtin_amdgcn_s_barrier()
#define PG8_SCHED __builtin_amdgcn_sched_barrier(0)
    Unit cur, nxt; int ui = 0;
    if (!S.next(0, cur)) return;
    f32x4 acc[2][2][4][2];
#pragma unroll
    for (int a = 0; a < 2; ++a)
#pragma unroll
        for (int b = 0; b < 2; ++b)
#pragma unroll
            for (int m = 0; m < 4; ++m)
#pragma unroll
                for (int n = 0; n < 2; ++n) acc[a][b][m][n] = (f32x4){0.f, 0.f, 0.f, 0.f};
    bf16x8 At[4][2], B0[2][2], B1[2][2];
    const char* cA = (const char*)g.A + (size_t)cur.pm * tstep; const char* cB = (const char*)g.Bt + (size_t)cur.pn * tstep;
    S.a_ready(cur);
    if constexpr (SP2) {
        PG8_STAGE(PG8_SB(0, 0), cB, voffB); PG8_STAGE(PG8_SB(0, 1), cB + hstep, voffB); PG8_STAGE(PG8_SA(0, 0), cA, voffA); PG8_STAGE(PG8_SA(0, 1), cA + hstep, voffA);
        if (wr == 1) PG8_BAR;
        PG8_WAIT_V(2); PG8_BAR;
        PG8_STAGE(PG8_SB(1, 0), cB + kstep, voffB); PG8_STAGE(PG8_SA(1, 0), cA + kstep, voffA); PG8_STAGE(PG8_SB(1, 1), cB + hstep + kstep, voffB);
        PG8_WAIT_V(6); PG8_BAR;
    } else {
        PG8_STAGE(PG8_SB(0, 0), cB, voffB); PG8_STAGE(PG8_SA(0, 0), cA, voffA); PG8_STAGE(PG8_SB(0, 1), cB + hstep, voffB); PG8_STAGE(PG8_SA(0, 1), cA + hstep, voffA);
        if (wr == 1) PG8_BAR;
        PG8_WAIT_V(4); PG8_BAR;
        PG8_STAGE(PG8_SB(1, 0), cB + kstep, voffB); PG8_STAGE(PG8_SA(1, 0), cA + kstep, voffA); PG8_STAGE(PG8_SB(1, 1), cB + hstep + kstep, voffB);
        PG8_WAIT_V(6); PG8_BAR;
    }
    for (;;) {
        const bool has_next = S.next(ui + 1, nxt);
        const char* nA = has_next ? (const char*)g.A + (size_t)nxt.pm * tstep : cA; const char* nB = has_next ? (const char*)g.Bt + (size_t)nxt.pn * tstep : cB;
        for (int t = 0; t < nt; t += 2) {
            const bool last = (t == nt - 2);
            const char* a1 = cA + (size_t)(t + 1) * kstep;
            const char* a2 = last ? nA : cA + (size_t)(t + 2) * kstep; const char* b2 = last ? nB : cB + (size_t)(t + 2) * kstep;
            const char* a3 = a2 + kstep; const char* b3 = b2 + kstep;
            if (last && has_next) S.a_ready(nxt);
            if constexpr (SP2) {
            PG8_LDB(B0, 0, 0); PG8_LDB(B1, 0, 1); PG8_SCHED; PG8_LDA(At, 0, 0); PG8_STAGE(PG8_SA(1, 1), a1 + hstep, voffA);
            PG8_WAIT_V(8); PG8_WAIT_L(0); PG8_BAR; PG8_MMA(0, 0, At, B0); PG8_MMA(0, 1, At, B1); PG8_BAR; PG8_SCHED;
            PG8_LDA(At, 0, 1); PG8_STAGE(PG8_SB(0, 0), b2, voffB); PG8_STAGE(PG8_SB(0, 1), b2 + hstep, voffB); PG8_STAGE(PG8_SA(0, 0), a2, voffA);
            PG8_WAIT_V(8); PG8_WAIT_L(0); PG8_BAR; PG8_MMA(1, 0, At, B0); PG8_MMA(1, 1, At, B1); PG8_BAR; PG8_SCHED;
            PG8_LDB(B0, 1, 0); PG8_LDB(B1, 1, 1); PG8_SCHED; PG8_LDA(At, 1, 0); PG8_STAGE(PG8_SA(0, 1), a2 + hstep, voffA);
            PG8_WAIT_V(8); PG8_WAIT_L(0); PG8_BAR; PG8_MMA(0, 0, At, B0); PG8_MMA(0, 1, At, B1); PG8_BAR; PG8_SCHED;
            PG8_LDA(At, 1, 1); PG8_STAGE(PG8_SB(1, 0), b3, voffB); PG8_STAGE(PG8_SB(1, 1), b3 + hstep, voffB); PG8_STAGE(PG8_SA(1, 0), a3, voffA);
            PG8_WAIT_V(8); PG8_WAIT_L(0); PG8_BAR; PG8_MMA(1, 0, At, B0); PG8_MMA(1, 1, At, B1); PG8_BAR; PG8_SCHED;
            } else {
            PG8_LDB(B0, 0, 0); PG8_SCHED; PG8_LDA(At, 0, 0); PG8_STAGE(PG8_SA(1, 1), a1 + hstep, voffA);
            PG8_WAIT_L(8); PG8_BAR; PG8_WAIT_L(0); PG8_MMA(0, 0, At, B0); PG8_BAR; PG8_SCHED;
            PG8_LDB(B1, 0, 1); PG8_STAGE(PG8_SB(0, 0), b2, voffB);
            PG8_BAR; PG8_WAIT_L(0); PG8_MMA(0, 1, At, B1); PG8_BAR;
            PG8_LDA(At, 0, 1); PG8_STAGE(PG8_SA(0, 0), a2, voffA);
            PG8_BAR; PG8_WAIT_L(0); PG8_MMA(1, 0, At, B0); PG8_BAR; PG8_SCHED;
            PG8_STAGE(PG8_SB(0, 1), b2 + hstep, voffB);
            PG8_WAIT_V(6); PG8_BAR; PG8_MMA(1, 1, At, B1); PG8_BAR;
            PG8_LDB(B0, 1, 0); PG8_SCHED; PG8_LDA(At, 1, 0); PG8_STAGE(PG8_SA(0, 1), a2 + hstep, voffA);
            PG8_WAIT_L(8); PG8_BAR; PG8_WAIT_L(0); PG8_MMA(0, 0, At, B0); PG8_BAR; PG8_SCHED;
            PG8_LDB(B1, 1, 1); PG8_STAGE(PG8_SB(1, 0), b3, voffB);
            PG8_BAR; PG8_WAIT_L(0); PG8_MMA(0, 1, At, B1); PG8_BAR;
            PG8_LDA(At, 1, 1); PG8_STAGE(PG8_SA(1, 0), a3, voffA);
            PG8_BAR; PG8_WAIT_L(0); PG8_MMA(1, 0, At, B0); PG8_BAR; PG8_SCHED;
            PG8_STAGE(PG8_SB(1, 1), b3 + hstep, voffB);
            PG8_WAIT_V(6); PG8_BAR; PG8_MMA(1, 1, At, B1); PG8_BAR;
            }
        }
        if constexpr (ALIGN_EPI) { if (wr == 0) PG8_BAR; }
        if constexpr (!Epi::AFTER_DRAIN) { E(acc, cur, wr, wc, fr, fq); S.done(cur); }
        if (!has_next) break;
#pragma unroll
        for (int a = 0; a < 2; ++a)
#pragma unroll
            for (int b = 0; b < 2; ++b)
#pragma unroll
                for (int m = 0; m < 4; ++m)
#pragma unroll
                    for (int n = 0; n < 2; ++n) acc[a][b][m][n] = (f32x4){0.f, 0.f, 0.f, 0.f};
        cur = nxt; cA = nA; cB = nB; ++ui;
        if constexpr (ALIGN_EPI) { if (wr == 1) PG8_BAR; }
    }
    PG8_WAIT_V(0);
    if constexpr (!ALIGN_EPI) { if (wr == 0) PG8_BAR; }
    PG8_BAR;
    if constexpr (Epi::AFTER_DRAIN) { E.fused(acc, cur, wr, wc, fr, fq, lds, wid, lane); S.done(cur); }
#undef PG8_SA
#undef PG8_SB
#undef PG8_STAGE
#undef PG8_LDA
#undef PG8_LDB
#undef PG8_MMA
#undef PG8_WAIT_V
#undef PG8_WAIT_L
#undef PG8_BAR
#undef PG8_SCHED
}
}

#define LAS __attribute__((address_space(3)))
typedef unsigned short bf16_t;
typedef short bf16x8 __attribute__((ext_vector_type(8)));
typedef float f32x4 __attribute__((ext_vector_type(4)));
typedef unsigned u32x4 __attribute__((ext_vector_type(4)));
typedef unsigned u32x2 __attribute__((ext_vector_type(2)));
using pg8::cvt_pk_bf16; using pg8::bflo; using pg8::bfhi; using pg8::sigm; using pg8::f32x2_t;

#ifndef MK_COOP
#define MK_COOP 1
#endif
constexpr int NWAVES = 8, NTHR = 512;
constexpr int BATCH = 8, SEQ = 4096, D = 1024, M = BATCH * SEQ, DIN = 3072, FF = 4096, PLE = 256, DC = 512, DR = 512, NH = 4, HD = 128, CH = 64, NCHUNK = SEQ / CH;
constexpr int NUNIT = BATCH * NH * NCHUNK;
constexpr float EPS = 1e-6f;
constexpr int N_PHASES = 9;
constexpr size_t MiB = 1u << 20;
constexpr size_t WS_PCNT = 576 * 1024;
constexpr size_t WS_BAR = 512 * 1024;
constexpr size_t WS_RSTD1 = 0, WS_SSQ2 = 128 * 1024, WS_SSQE = 256 * 1024, WS_SSQ3 = 384 * 1024, WS_DEC = 1 * MiB;
constexpr size_t WS_WIN = 2 * MiB, WS_WOUT = 8 * MiB, WS_WUP = 10 * MiB, WS_WDOWN = 18 * MiB, WS_WPLE = 26 * MiB, WS_WGATE = 27 * MiB;
constexpr size_t WS_XB = 32 * MiB;
constexpr size_t WS_PB = 96 * MiB;
constexpr size_t WS_CGLU = 112 * MiB, WS_QB = 144 * MiB, WS_GS = 176 * MiB, WS_LOGF = 208 * MiB, WS_VB = 272 * MiB, WS_UT = 304 * MiB;
constexpr size_t WS_T = 112 * MiB;
constexpr size_t WS_Y = 368 * MiB;
constexpr size_t WS_E = 432 * MiB;
constexpr size_t WS_ASEG = 496 * MiB, WS_ESEG = 504 * MiB;
constexpr size_t WS_DSEG = 29 * MiB;
constexpr size_t WS_END = 512 * MiB;
constexpr int LDS_BYTES = 147456;

__device__ __forceinline__ float wave_sum(float v) {
#pragma unroll
    for (int o = 1; o < 64; o <<= 1) v += __shfl_xor(v, o);
    return v;
}
#define LDS_WAIT() asm volatile("s_waitcnt lgkmcnt(0)" ::: "memory")

__device__ __forceinline__ void transpose_item(const float* W, int K, int N, bf16_t* WT, int mode, const float* gain, LAS float* scr, int item, int lane) {
    const int nblk = N / 32, kb = item / nblk, nb = item % nblk, k0 = 64 * kb, n0 = 32 * nb;
#pragma unroll 8
    for (int i = 0; i < 32; ++i) { const int kk = 2 * i + (lane >> 5); float w = __builtin_nontemporal_load(W + (size_t)(k0 + kk) * N + n0 + (lane & 31)); if (gain) w *= gain[k0 + kk]; scr[kk * 33 + (lane & 31)] = w; }
    LDS_WAIT();
    int drow0 = n0;
    if (mode == 1) { const int region = n0 >> 9, within = n0 & 511, j = within >> 7, c0 = within & 127;
        int tile, bj;
        switch (region) { case 0: tile = j; bj = 0; break; case 1: tile = j; bj = 1; break; case 2: tile = 4 + j; bj = 0; break;
                          case 3: tile = 8 + j; bj = 0; break; case 4: tile = 8 + j; bj = 1; break; default: tile = 4 + j; bj = 1; break; }
        drow0 = tile * 256 + bj * 128 + c0; }
    const int c = lane & 7;
#pragma unroll
    for (int j = 0; j < 4; ++j) { const int n = (lane >> 3) + 8 * j; const LAS float* s = scr + (8 * c) * 33 + n;
        u32x4 o; o.x = cvt_pk_bf16(s[0 * 33], s[1 * 33]); o.y = cvt_pk_bf16(s[2 * 33], s[3 * 33]); o.z = cvt_pk_bf16(s[4 * 33], s[5 * 33]); o.w = cvt_pk_bf16(s[6 * 33], s[7 * 33]);
        *(u32x4*)(WT + (size_t)(drow0 + n) * K + k0 + 8 * c) = o; }
    LDS_WAIT();
}

typedef __attribute__((address_space(1))) unsigned gu32;
#define XB_TMO      128
#define XB_XCNT(j)  (256  + 64 * (j))
#define XB_XSUB(j)  (1280 + 64 * (j))
#define XB_XGEN(j)  (2304 + 64 * (j))
#define XB_TOP      3328
#define XB_TOPGEN   3392
#define XCD_BAR_WORDS 3456
#define XB_SPIN_CAP (1u << 18)

__device__ __forceinline__ unsigned xb_ld(unsigned* p)              { return __hip_atomic_load(p, __ATOMIC_RELAXED, __HIP_MEMORY_SCOPE_AGENT); }
__device__ __forceinline__ unsigned xb_add(unsigned* p, unsigned v) { return __hip_atomic_fetch_add(p, v, __ATOMIC_RELAXED, __HIP_MEMORY_SCOPE_AGENT); }
__device__ __forceinline__ unsigned xb_xcc_id() { return (unsigned)__builtin_amdgcn_s_getreg((3 << 11) | 20) & 0xFu; }
#define XB_SPIN(cond, bar) do { unsigned _sp = 0; while (cond) { __builtin_amdgcn_s_sleep(1); \
    if ((++_sp & 255u) == 0u) { if (xb_ld(&(bar)[XB_TMO])) break; if (_sp > XB_SPIN_CAP) { atomicAdd(&(bar)[XB_TMO], 1u); break; } } } } while (0)

struct XcdBarrier {
    unsigned* bar; unsigned x;
    volatile LAS unsigned* st;
};

__device__ __forceinline__ XcdBarrier xcd_barrier_post(unsigned* bar, volatile LAS unsigned* st) {
    XcdBarrier b; b.bar = bar; b.x = xb_xcc_id(); b.st = st;
    if (threadIdx.x == 0) (void)xb_add(&bar[XB_XCNT(b.x)], 1u);
    return b;
}
__device__ __forceinline__ void xcd_barrier_complete(unsigned* bar, unsigned x, unsigned& nloc, unsigned& nx) {
    const unsigned G = gridDim.x * gridDim.y * gridDim.z;
    unsigned sum, cnt, mine, sp = 0u;
    for (;;) {
        sum = 0u; cnt = 0u; mine = 0u;
#pragma unroll
        for (unsigned j = 0; j < 16; ++j) { const unsigned c = xb_ld(&bar[XB_XCNT(j)]); sum += c; cnt += (c > 0u) ? 1u : 0u; mine = (j == x) ? c : mine; }
        if (sum == G) break;
        __builtin_amdgcn_s_sleep(1);
        if ((++sp & 255u) == 0u) { if (xb_ld(&bar[XB_TMO])) break; if (sp > XB_SPIN_CAP) { atomicAdd(&bar[XB_TMO], 1u); break; } }
    }
    nloc = mine > 0u ? mine : 1u; nx = cnt > 0u ? cnt : 1u;
}

__device__ __forceinline__ void xcd_barrier(const XcdBarrier& b) {
    asm volatile("s_waitcnt vmcnt(0)" ::: "memory");
    __syncthreads();
    if (threadIdx.x == 0) {
        unsigned* bar = b.bar;
        __builtin_amdgcn_s_waitcnt(0);
        unsigned nloc = b.st[0], nx = b.st[1];
        if (nloc == 0u) { xcd_barrier_complete(bar, b.x, nloc, nx); b.st[0] = nloc; b.st[1] = nx; }
        const unsigned old = xb_add(&bar[XB_XSUB(b.x)], 1u);
        const unsigned gen = old / nloc;
        if (old + 1u == (gen + 1u) * nloc) {
            __builtin_amdgcn_fence(__ATOMIC_RELEASE, "agent");
            asm volatile("s_waitcnt vmcnt(0)" ::: "memory");
            const unsigned og = xb_add(&bar[XB_TOP], 1u);
            const unsigned tg = og / nx;
            if (og + 1u == (tg + 1u) * nx) xb_add(&bar[XB_TOPGEN], 1u);
            else XB_SPIN(xb_ld(&bar[XB_TOPGEN]) == tg, bar);
            __builtin_amdgcn_fence(__ATOMIC_ACQUIRE, "agent");
            xb_add(&bar[XB_XGEN(b.x)], 1u);
            asm volatile("s_waitcnt vmcnt(0)" ::: "memory");
        } else {
            XB_SPIN(xb_ld(&bar[XB_XGEN(b.x)]) == gen, bar);
            __builtin_amdgcn_fence(__ATOMIC_ACQUIRE, "agent");
            asm volatile("s_waitcnt vmcnt(0)" ::: "memory");
        }
    }
    __syncthreads();
}

struct Args { const float* in[18]; float* out; unsigned char* ws; int ph_lo, ph_hi; };

__global__ void __launch_bounds__(NTHR, 2) mk_fwd(Args args) {
    extern __shared__ __attribute__((aligned(16))) unsigned char lds_raw[];
    LAS unsigned char* lds = (LAS unsigned char*)lds_raw;
    cg::grid_group grid = cg::this_grid();
    const int tid = threadIdx.x, lane = tid & 63, wave = __builtin_amdgcn_readfirstlane(tid >> 6);
    const int G = gridDim.x, gw = blockIdx.x * NWAVES + wave, NGW = G * NWAVES;
    const int lo = args.ph_lo, hi = args.ph_hi;
    unsigned char* const ws = args.ws;
#define xin (args.in[0])
#define outp (args.out)
#define rstd1 ((float*)(ws + WS_RSTD1))
#define ssq2 ((float*)(ws + WS_SSQ2))
#define ssqE ((float*)(ws + WS_SSQE))
#define ssq3 ((float*)(ws + WS_SSQ3))
#define dec ((float*)(ws + WS_DEC))
#define WinT ((bf16_t*)(ws + WS_WIN))
#define WoutT ((bf16_t*)(ws + WS_WOUT))
#define WupT ((bf16_t*)(ws + WS_WUP))
#define WdownT ((bf16_t*)(ws + WS_WDOWN))
#define WpleT ((bf16_t*)(ws + WS_WPLE))
#define WgateT ((bf16_t*)(ws + WS_WGATE))
#define xb ((bf16_t*)(ws + WS_XB))
#define pb ((bf16_t*)(ws + WS_PB))
#define cglu ((bf16_t*)(ws + WS_CGLU))
#define qb ((bf16_t*)(ws + WS_QB))
#define gs ((bf16_t*)(ws + WS_GS))
#define logf ((_Float16*)(ws + WS_LOGF))
#define vb ((bf16_t*)(ws + WS_VB))
#define Ut ((bf16_t*)(ws + WS_UT))
#define tb ((bf16_t*)(ws + WS_T))
#define yb ((bf16_t*)(ws + WS_Y))
#define eb ((bf16_t*)(ws + WS_E))
#define Aseg ((bf16_t*)(ws + WS_ASEG))
#define Eseg ((bf16_t*)(ws + WS_ESEG))
#define Dseg ((float*)(ws + WS_DSEG))
#define IN(k) (lo <= (k) && (k) < hi)
#ifndef DBG_TS
#define DBG_TS -1
#endif
    volatile LAS unsigned* bar_st = (volatile LAS unsigned*)(lds + 147328 + 64);
    if (tid < 2) bar_st[tid] = 0u;
    __syncthreads();
    XcdBarrier bar; bar.bar = (unsigned*)(ws + WS_BAR); bar.x = 0; bar.st = bar_st;
    if (hi - lo > 1) bar = xcd_barrier_post((unsigned*)(ws + WS_BAR), bar_st);
    volatile LAS unsigned long long* tsw = (volatile LAS unsigned long long*)(lds + 147328);
    if (DBG_TS >= 0 && tid == 0) { tsw[0] = __builtin_amdgcn_s_memrealtime(); tsw[1] = 0ull; }
#define SEAM(k) do { if (IN(k) && IN((k) + 1)) { if (hi > N_PHASES) grid.sync(); else xcd_barrier(bar); } if (DBG_TS >= 0 && tid == 0) { const unsigned long long t_ = __builtin_amdgcn_s_memrealtime(); if ((k) == DBG_TS) tsw[1] = t_ - tsw[0]; tsw[0] = t_; } } while (0)

#define TSMARK(id) do { if (DBG_TS == (id) && tid == 0) tsw[1] = __builtin_amdgcn_s_memrealtime() - tsw[0]; } while (0)
    if (IN(0)) {
        LAS float* scr = (LAS float*)(lds + wave * 16384);
        constexpr int I_IN = (D / 64) * (DIN / 32);
        for (int it = gw; it < I_IN; it += NGW) transpose_item(args.in[3], D, DIN, WinT, 1, args.in[2], scr, it, lane);
        for (int m0 = gw; m0 < M; m0 += 2 * NGW) {
            f32x4 v[2][4];
#pragma unroll
            for (int r = 0; r < 2; ++r) { const int m = m0 + r * NGW; const f32x4* xr = (const f32x4*)(xin + (size_t)m * D) + lane;
#pragma unroll
                for (int j = 0; j < 4; ++j) v[r][j] = __builtin_nontemporal_load(xr + 64 * j); }
#pragma unroll
            for (int r = 0; r < 2; ++r) { const int m = m0 + r * NGW; float sq = 0.f;
#pragma unroll
                for (int j = 0; j < 4; ++j) sq += (v[r][j][0] * v[r][j][0] + v[r][j][1] * v[r][j][1]) + (v[r][j][2] * v[r][j][2] + v[r][j][3] * v[r][j][3]);
                sq = wave_sum(sq);
                if (lane == 0) rstd1[m] = sqrtf(sq * (1.0f / D) + EPS);
                u32x2* o8 = (u32x2*)(xb + (size_t)m * D) + lane;
                const float rs_ = __builtin_amdgcn_rsqf(sq * (1.0f / D) + EPS);
#pragma unroll
                for (int j = 0; j < 4; ++j) { u32x2 w; w.x = cvt_pk_bf16(v[r][j][0] * rs_, v[r][j][1] * rs_); w.y = cvt_pk_bf16(v[r][j][2] * rs_, v[r][j][3] * rs_); o8[64 * j] = w; } }
        }
        for (int i = blockIdx.x * NTHR + tid; i < M; i += G * NTHR) { ssq2[i] = 0.f; ssqE[i] = 0.f; ssq3[i] = 0.f; }
        __syncthreads();
    }
    SEAM(0);

    if (IN(1)) {
        { pg8::Gemm g{xb, WinT, M, DIN, D}; pg8::StaticOrder S; S.init(M, DIN, G, (int)blockIdx.x);
          pg8::EpiIn E{rstd1, args.in[8], cglu, qb, gs, logf, vb};
          pg8::gemm_phase<pg8::EpiIn, pg8::StaticOrder, true, true>(lds, g, S, E); }
    }
    SEAM(1);

    if (IN(2)) {
        {
            LAS float* scr = (LAS float*)(lds + wave * 15872);
            constexpr int I_OUT = (D / 64) * (D / 32), I_UP = (D / 64) * (FF / 32), I_DOWN = (FF / 64) * (D / 32), I_PLE = (PLE / 64) * (D / 32), I_GATE = I_OUT;
            constexpr int NIT2 = I_OUT + I_UP + I_DOWN + I_PLE + I_GATE;
            for (int it = gw; it < NIT2; it += NGW) {
                int r = it;
                if (r < I_OUT) { transpose_item(args.in[10], D, D, WoutT, 0, nullptr, scr, r, lane); continue; } r -= I_OUT;
                if (r < I_UP) { transpose_item(args.in[12], D, FF, WupT, 0, args.in[11], scr, r, lane); continue; } r -= I_UP;
                if (r < I_DOWN) { transpose_item(args.in[13], FF, D, WdownT, 0, nullptr, scr, r, lane); continue; } r -= I_DOWN;
                if (r < I_PLE) { transpose_item(args.in[14], PLE, D, WpleT, 0, nullptr, scr, r, lane); continue; } r -= I_PLE;
                transpose_item(args.in[16], D, D, WgateT, 0, nullptr, scr, r, lane);
            }
            for (int m0 = gw; m0 < M; m0 += 4 * NGW) {
                f32x4 pv[4];
#pragma unroll
                for (int r = 0; r < 4; ++r) pv[r] = __builtin_nontemporal_load((const f32x4*)(args.in[1] + (size_t)(m0 + r * NGW) * PLE) + lane);
#pragma unroll
                for (int r = 0; r < 4; ++r) { u32x2 w; w.x = cvt_pk_bf16(pv[r][0], pv[r][1]); w.y = cvt_pk_bf16(pv[r][2], pv[r][3]); *((u32x2*)(pb + (size_t)(m0 + r * NGW) * PLE) + lane) = w; }
            }
        }
        {
            typedef float f32x2 __attribute__((ext_vector_type(2)));
            LAS bf16_t* Xs = (LAS bf16_t*)(lds + wave * 15872);
            const float* cw = args.in[4]; const float* cbias = args.in[5]; const float* lng = args.in[6]; const float* lnb = args.in[7];
            for (int uidx = gw; uidx < (M / 32) * 4; uidx += NGW) {
                const int tile = uidx >> 2, cb = uidx & 3, b = tile >> 7, t0 = (tile & 127) * 32;
                const int rr = lane >> 4, c16 = lane & 15;
#pragma unroll 4
                for (int it = 0; it < 16; ++it) { const int i = it * 4 + rr; const int t = t0 - 30 + i;
                    if (i < 62) { u32x4 v = {0u, 0u, 0u, 0u}; if (t >= 0) v = __builtin_nontemporal_load((const u32x4*)(cglu + ((size_t)b * SEQ + t) * DC + cb * 128 + c16 * 8));
                        *(LAS u32x4*)(Xs + i * 128 + c16 * 8) = v; } }
                const int ch = cb * 128 + 2 * lane;
                f32x2 wj[31];
#pragma unroll
                for (int j = 0; j < 31; ++j) wj[j] = *(const f32x2*)(cw + j * DC + ch);
                const f32x2 bias = *(const f32x2*)(cbias + ch), gg = *(const f32x2*)(lng + ch), bb = *(const f32x2*)(lnb + ch);
                LDS_WAIT();
                for (int tblk = 0; tblk < 8; ++tblk) {
                    f32x2 xs[34];
#pragma unroll
                    for (int i = 0; i < 34; ++i) { const unsigned w = *(const LAS unsigned*)(Xs + (tblk * 4 + i) * 128 + 2 * lane); xs[i] = (f32x2){bflo(w), bfhi(w)}; }
                    f32x2 av[4]; float s1[4], s2[4];
#pragma unroll
                    for (int o = 0; o < 4; ++o) { f32x2 a = bias;
#pragma unroll
                        for (int j = 0; j < 31; ++j) a = __builtin_elementwise_fma(wj[j], xs[o + j], a);
                        av[o] = a; s1[o] = a.x + a.y; s2[o] = a.x * a.x + a.y * a.y; }
#pragma unroll
                    for (int st = 1; st < 32; st <<= 1) {
#pragma unroll
                        for (int o = 0; o < 4; ++o) { s1[o] += __shfl_xor(s1[o], st); s2[o] += __shfl_xor(s2[o], st); } }
#pragma unroll
                    for (int o = 0; o < 4; ++o) { const float mu = s1[o] * (1.0f / 64.0f); const float var = fmaxf(s2[o] * (1.0f / 64.0f) - mu * mu, 0.f);
                        const float rs = __builtin_amdgcn_rsqf(var + EPS);
                        f32x2 yv = (av[o] - mu) * rs * gg + bb; yv.x = yv.x * sigm(yv.x); yv.y = yv.y * sigm(yv.y);
                        *(unsigned*)(yb + ((size_t)b * SEQ + t0 + tblk * 4 + o) * D + ch) = cvt_pk_bf16(yv.x, yv.y); }
                }
                LDS_WAIT();
            }
        }
        __syncthreads();
        {
            LAS bf16_t* Kt = (LAS bf16_t*)(lds);
            LAS bf16_t* Vt = (LAS bf16_t*)(lds + 18432);
            LAS float* PT = (LAS float*)(lds + 57344);
            LAS float* DEC = (LAS float*)(lds + 38912);
            LAS _Float16* RawLF = (LAS _Float16*)(lds + 40960);
            const int dp = tid & 63, part = tid >> 6, l15 = lane & 15, lq = lane >> 4;
            typedef _Float16 h2v __attribute__((ext_vector_type(2)));
            u32x4 lfr[2], vvn[2];
#define H1_LOAD(unit_) do { const int c_ = (unit_) & 63, bh_ = (unit_) >> 6, h_ = bh_ & 3, b_ = bh_ >> 2; const size_t r0_ = (size_t)b_ * SEQ + 64 * c_; \
                _Pragma("unroll") for (int it = 0; it < 2; ++it) { const int idx = tid + 512 * it; lfr[it] = *(const u32x4*)(logf + (r0_ + (idx >> 4)) * DR + h_ * HD + (idx & 15) * 8); } \
                _Pragma("unroll") for (int it = 0; it < 2; ++it) { const int idx = tid + 512 * it, s = idx >> 4, e8 = idx & 15; vvn[it] = *(const u32x4*)(vb + (r0_ + s) * DR + h_ * HD + e8 * 8); } } while (0)
            const int segid = (int)blockIdx.x;
            const int unit0 = ((segid >> 3) << 6) | ((segid & 7) << 3);
            f32x4 Srun[8];
#pragma unroll
            for (int et = 0; et < 8; ++et) Srun[et] = (f32x4){0.f, 0.f, 0.f, 0.f};
            float dpre0 = 1.0f, dpre1 = 1.0f;
            const int d0 = 16 * wave;
            if (segid < BATCH * NH * 8) {
            H1_LOAD(unit0);
            for (int k = 0; k < 8; ++k) { const int unit = unit0 + k;
                float lf[16]; u32x4 vv[2];
#pragma unroll
                for (int it = 0; it < 2; ++it) { const int idx = tid + 512 * it; *(LAS u32x4*)(RawLF + (idx >> 4) * 128 + (idx & 15) * 8) = lfr[it]; }
                vv[0] = vvn[0]; vv[1] = vvn[1];
#pragma unroll
                for (int it = 0; it < 2; ++it) { const int idx = tid + 512 * it, s = idx >> 4, e8 = idx & 15;
#pragma unroll
                    for (int j = 0; j < 4; ++j) { const unsigned w = vv[it][j]; Vt[(e8 * 8 + 2 * j) * 72 + (s ^ ((e8 & 7) << 3))] = (bf16_t)(w & 0xffffu); Vt[(e8 * 8 + 2 * j + 1) * 72 + (s ^ ((e8 & 7) << 3))] = (bf16_t)(w >> 16); } }
                if (k + 1 < 8) H1_LOAD(unit + 1);
                __syncthreads();
                float lf0[8], lf1[8], bc0[8], bc1[8]; float run0 = 0.f, run1 = 0.f;
#pragma unroll
                for (int i = 0; i < 8; ++i) { const f32x2_t v2 = __builtin_convertvector(__builtin_bit_cast(h2v, *(const LAS unsigned*)(RawLF + (8 * part + i) * 128 + 2 * dp)), f32x2_t);
                    lf0[i] = v2.x; lf1[i] = v2.y; run0 += v2.x; run1 += v2.y; bc0[i] = run0; bc1[i] = run1; }
                *(LAS f32x2_t*)(PT + part * 128 + 2 * dp) = (f32x2_t){run0, run1};
                __syncthreads();
                float off0 = 0.f, off1 = 0.f;
#pragma unroll
                for (int p = 0; p < 7; ++p) if (p < part) { const f32x2_t pv = *(const LAS f32x2_t*)(PT + p * 128 + 2 * dp); off0 += pv.x; off1 += pv.y; }
                unsigned k0w[4], k1w[4];
#pragma unroll
                for (int i = 0; i < 8; i += 2) { const float ba = bc0[i] + off0, bb_ = bc0[i + 1] + off0, bc_ = bc1[i] + off1, bd = bc1[i + 1] + off1;
                    k0w[i >> 1] = cvt_pk_bf16((1.0f - __expf(lf0[i])) * __expf(-ba), (1.0f - __expf(lf0[i + 1])) * __expf(-bb_));
                    k1w[i >> 1] = cvt_pk_bf16((1.0f - __expf(lf1[i])) * __expf(-bc_), (1.0f - __expf(lf1[i + 1])) * __expf(-bd)); }
                *(LAS u32x4*)(Kt + (2 * dp) * 72 + 8 * (part ^ ((dp >> 3) & 7))) = (u32x4){k0w[0], k0w[1], k0w[2], k0w[3]};
                *(LAS u32x4*)(Kt + (2 * dp + 1) * 72 + 8 * (part ^ ((dp >> 3) & 7))) = (u32x4){k1w[0], k1w[1], k1w[2], k1w[3]};
                if (part == 7) { const float dc0 = __expf(bc0[7] + off0), dc1 = __expf(bc1[7] + off1); *(LAS f32x2_t*)(DEC + 2 * dp) = (f32x2_t){dc0, dc1}; dpre0 *= dc0; dpre1 *= dc1; }
                __syncthreads();
                bf16x8 a[2];
#pragma unroll
                for (int kk = 0; kk < 2; ++kk) a[kk] = *(const LAS bf16x8*)(Kt + (d0 + l15) * 72 + 8 * ((lq + 4 * kk) ^ (wave & 7)));
                const f32x4 dv = *(const LAS f32x4*)(DEC + d0 + 4 * lq);
#pragma unroll
                for (int et = 0; et < 8; ++et) { f32x4 acc = {0.f, 0.f, 0.f, 0.f};
#pragma unroll
                    for (int kk = 0; kk < 2; ++kk) { const bf16x8 bf = *(const LAS bf16x8*)(Vt + (16 * et + l15) * 72 + 8 * ((lq + 4 * kk) ^ ((2 * et + (l15 >> 3)) & 7))); acc = __builtin_amdgcn_mfma_f32_16x16x32_bf16(a[kk], bf, acc, 0, 0, 0); }
                    Srun[et] = dv * (Srun[et] + acc); }
                __syncthreads();
            }
#pragma unroll
            for (int et = 0; et < 8; ++et) { u32x2 w2; w2.x = cvt_pk_bf16(Srun[et][0], Srun[et][1]); w2.y = cvt_pk_bf16(Srun[et][2], Srun[et][3]);
                *(u32x2*)(Aseg + (size_t)segid * (HD * HD) + (16 * et + l15) * HD + d0 + 4 * lq) = w2; }
            if (part == 7) *(f32x2_t*)(Dseg + segid * HD + 2 * dp) = (f32x2_t){dpre0, dpre1};
            }
        }
    }
    SEAM(2);

    if (IN(3)) {
        for (int idx = blockIdx.x * NTHR + tid; idx < BATCH * NH * HD * (HD / 4); idx += G * NTHR) {
            const int bh = idx >> 12, el = idx & 4095, d4 = el & 31;
            float E0 = 0.f, E1 = 0.f, E2 = 0.f, E3 = 0.f;
#pragma unroll
            for (int j = 0; j < 8; ++j) { const size_t o = (size_t)(bh * 8 + j) * (HD * HD) + (size_t)el * 4;
                const u32x2 av = *(const u32x2*)(Aseg + o); const f32x4 dv = *(const f32x4*)(Dseg + (bh * 8 + j) * HD + d4 * 4);
                u32x2 sv; sv.x = cvt_pk_bf16(E0, E1); sv.y = cvt_pk_bf16(E2, E3); *(u32x2*)(Eseg + o) = sv;
                E0 = bflo(av.x) + dv[0] * E0; E1 = bfhi(av.x) + dv[1] * E1; E2 = bflo(av.y) + dv[2] * E2; E3 = bfhi(av.y) + dv[3] * E3; }
        }
    }
    SEAM(3);

    if (IN(4)) {
        LAS bf16_t* Qs = (LAS bf16_t*)(lds);
        LAS bf16_t* Ks = (LAS bf16_t*)(lds + 17408);
        LAS bf16_t* Vt = (LAS bf16_t*)(lds + 34816);
        LAS bf16_t* St = (LAS bf16_t*)(lds + 53248);
        LAS bf16_t* As = (LAS bf16_t*)(lds + 88064);
        LAS float* PT = (LAS float*)(lds + 135168);
        LAS float* SS = (LAS float*)(lds + 99328);
        LAS _Float16* RawLF = (LAS _Float16*)(lds);
        LAS bf16_t* RawQ = (LAS bf16_t*)(lds + 99840);
        LAS bf16_t* Kt = (LAS bf16_t*)(lds + 116224);
        LAS float* DEC = (LAS float*)(lds + 134656);
        const float* recg = args.in[9];
        const int dp = tid & 63, part = tid >> 6, l15 = lane & 15, lq = lane >> 4;
        typedef _Float16 h2v __attribute__((ext_vector_type(2)));
        u32x4 lfr[2], qr[2], vvn[2]; u32x2 gvn[4]; f32x4 rgn[4];
        const int o_tt = wave & 3, o_eh = wave >> 2;
#define H3_LOAD(unit_) do { const int c_ = (unit_) & 63, bh_ = (unit_) >> 6, h_ = bh_ & 3, b_ = bh_ >> 2; const size_t r0_ = (size_t)b_ * SEQ + 64 * c_; \
            _Pragma("unroll") for (int it = 0; it < 2; ++it) { const int idx = tid + 512 * it; lfr[it] = __builtin_nontemporal_load((const u32x4*)(logf + (r0_ + (idx >> 4)) * DR + h_ * HD + (idx & 15) * 8)); } \
            _Pragma("unroll") for (int it = 0; it < 2; ++it) { const int idx = tid + 512 * it; qr[it] = __builtin_nontemporal_load((const u32x4*)(qb + (r0_ + (idx >> 4)) * DR + h_ * HD + (idx & 15) * 8)); } \
            _Pragma("unroll") for (int it = 0; it < 2; ++it) { const int idx = tid + 512 * it, s = idx >> 4, e8 = idx & 15; vvn[it] = __builtin_nontemporal_load((const u32x4*)(vb + (r0_ + s) * DR + h_ * HD + e8 * 8)); } \
            _Pragma("unroll") for (int et = 0; et < 4; ++et) { const int e_ = 16 * (4 * o_eh + et) + 4 * lq; gvn[et] = __builtin_nontemporal_load((const u32x2*)(gs + (r0_ + 16 * o_tt + l15) * DR + h_ * HD + e_)); rgn[et] = *(const f32x4*)(recg + h_ * HD + e_); } } while (0)
        const int segid = (int)blockIdx.x, unit0 = ((segid >> 3) << 6) | ((segid & 7) << 3);
        if (segid < BATCH * NH * 8) {
        const int d0 = 16 * wave;
        f32x4 Srun[8];
#pragma unroll
        for (int et = 0; et < 8; ++et) { const u32x2 ev = *(const u32x2*)(Eseg + (size_t)segid * (HD * HD) + (16 * et + l15) * HD + d0 + 4 * lq); Srun[et] = (f32x4){bflo(ev.x), bfhi(ev.x), bflo(ev.y), bfhi(ev.y)}; }
        H3_LOAD(unit0);
        for (int k8 = 0; k8 < 8; ++k8) { const int unit = unit0 + k8;
            const int c = unit & 63, bh = unit >> 6, h = bh & 3, b = bh >> 2; const size_t r0 = (size_t)b * SEQ + 64 * c;
            float lf[16]; float qv[16]; u32x4 vv[2];
#pragma unroll
            for (int it = 0; it < 2; ++it) { const int idx = tid + 512 * it; *(LAS u32x4*)(RawLF + (idx >> 4) * 128 + (idx & 15) * 8) = lfr[it]; }
#pragma unroll
            for (int it = 0; it < 2; ++it) { const int idx = tid + 512 * it; *(LAS u32x4*)(RawQ + (idx >> 4) * 128 + (idx & 15) * 8) = qr[it]; }
            vv[0] = vvn[0]; vv[1] = vvn[1];
#pragma unroll
            for (int et = 0; et < 8; ++et) { u32x2 w2; w2.x = cvt_pk_bf16(Srun[et][0], Srun[et][1]); w2.y = cvt_pk_bf16(Srun[et][2], Srun[et][3]); *(LAS u32x2*)(St + (16 * et + l15) * 136 + d0 + 4 * lq) = w2; }
            u32x2 gv[4]; f32x4 rgv[4];
#pragma unroll
            for (int et = 0; et < 4; ++et) { gv[et] = gvn[et]; rgv[et] = rgn[et]; }
#pragma unroll
            for (int it = 0; it < 2; ++it) { const int idx = tid + 512 * it, s = idx >> 4, e8 = idx & 15;
#pragma unroll
                for (int j = 0; j < 4; ++j) { const unsigned w = vv[it][j]; Vt[(e8 * 8 + 2 * j) * 72 + (s ^ ((e8 & 7) << 3))] = (bf16_t)(w & 0xffffu); Vt[(e8 * 8 + 2 * j + 1) * 72 + (s ^ ((e8 & 7) << 3))] = (bf16_t)(w >> 16); } }
            if (k8 + 1 < 8) H3_LOAD(unit + 1);
            __syncthreads();
            float lf0[8], lf1[8], q0[8], q1[8], bc0[8], bc1[8]; float run0 = 0.f, run1 = 0.f;
#pragma unroll
            for (int i = 0; i < 8; ++i) { const f32x2_t v2 = __builtin_convertvector(__builtin_bit_cast(h2v, *(const LAS unsigned*)(RawLF + (8 * part + i) * 128 + 2 * dp)), f32x2_t);
                const unsigned qw = *(const LAS unsigned*)(RawQ + (8 * part + i) * 128 + 2 * dp); q0[i] = bflo(qw); q1[i] = bfhi(qw);
                lf0[i] = v2.x; lf1[i] = v2.y; run0 += v2.x; run1 += v2.y; bc0[i] = run0; bc1[i] = run1; }
            *(LAS f32x2_t*)(PT + part * 128 + 2 * dp) = (f32x2_t){run0, run1};
            __syncthreads();
            float off0 = 0.f, off1 = 0.f;
#pragma unroll
            for (int p = 0; p < 7; ++p) if (p < part) { const f32x2_t pv = *(const LAS f32x2_t*)(PT + p * 128 + 2 * dp); off0 += pv.x; off1 += pv.y; }
            unsigned k0w[4], k1w[4];
#pragma unroll
            for (int i = 0; i < 8; i += 2) {
                float kk0[2], kk1[2];
#pragma unroll
                for (int u2 = 0; u2 < 2; ++u2) { const float ba = bc0[i + u2] + off0, bb_ = bc1[i + u2] + off1;
                    const float qa = q0[i + u2] * __expf(ba), qb_ = q1[i + u2] * __expf(bb_);
                    kk0[u2] = (1.0f - __expf(lf0[i + u2])) * __expf(-ba); kk1[u2] = (1.0f - __expf(lf1[i + u2])) * __expf(-bb_);
                    *(LAS unsigned*)(Qs + (8 * part + i + u2) * 136 + 2 * dp) = cvt_pk_bf16(qa, qb_);
                    *(LAS unsigned*)(Ks + (8 * part + i + u2) * 136 + 2 * dp) = cvt_pk_bf16(kk0[u2], kk1[u2]); }
                k0w[i >> 1] = cvt_pk_bf16(kk0[0], kk0[1]); k1w[i >> 1] = cvt_pk_bf16(kk1[0], kk1[1]); }
            *(LAS u32x4*)(Kt + (2 * dp) * 72 + 8 * (part ^ ((dp >> 3) & 7))) = (u32x4){k0w[0], k0w[1], k0w[2], k0w[3]};
            *(LAS u32x4*)(Kt + (2 * dp + 1) * 72 + 8 * (part ^ ((dp >> 3) & 7))) = (u32x4){k1w[0], k1w[1], k1w[2], k1w[3]};
            if (part == 7) *(LAS f32x2_t*)(DEC + 2 * dp) = (f32x2_t){__expf(bc0[7] + off0), __expf(bc1[7] + off1)};
            __syncthreads();
            {
                bf16x8 ka[2];
#pragma unroll
                for (int kk = 0; kk < 2; ++kk) ka[kk] = *(const LAS bf16x8*)(Kt + (d0 + l15) * 72 + 8 * ((lq + 4 * kk) ^ (wave & 7)));
                const f32x4 dv = *(const LAS f32x4*)(DEC + d0 + 4 * lq);
#pragma unroll
                for (int et = 0; et < 8; ++et) { f32x4 acc = {0.f, 0.f, 0.f, 0.f};
#pragma unroll
                    for (int kk = 0; kk < 2; ++kk) { const bf16x8 bf = *(const LAS bf16x8*)(Vt + (16 * et + l15) * 72 + 8 * ((lq + 4 * kk) ^ ((2 * et + (l15 >> 3)) & 7))); acc = __builtin_amdgcn_mfma_f32_16x16x32_bf16(ka[kk], bf, acc, 0, 0, 0); }
                    Srun[et] = dv * (Srun[et] + acc); }
            }
            {
                const int tt = wave >> 1;
#pragma unroll
                for (int sti = 0; sti < 2; ++sti) { const int st = 2 * (wave & 1) + sti; f32x4 acc = {0.f, 0.f, 0.f, 0.f};
                    if (st <= tt) {
#pragma unroll
                        for (int kk = 0; kk < 4; ++kk) { const bf16x8 ak = *(const LAS bf16x8*)(Ks + (16 * st + l15) * 136 + 8 * lq + 32 * kk); const bf16x8 bq = *(const LAS bf16x8*)(Qs + (16 * tt + l15) * 136 + 8 * lq + 32 * kk);
                            acc = __builtin_amdgcn_mfma_f32_16x16x32_bf16(ak, bq, acc, 0, 0, 0); } }
                    const int t = 16 * tt + l15, s0 = 16 * st + 4 * lq;
#pragma unroll
                    for (int r = 0; r < 4; ++r) if (s0 + r > t) acc[r] = 0.f;
                    u32x2 w2; w2.x = cvt_pk_bf16(acc[0], acc[1]); w2.y = cvt_pk_bf16(acc[2], acc[3]);
                    *(LAS u32x2*)(As + t * 72 + s0) = w2; }
            }
            __syncthreads();
            {
                const int tt = wave & 3, eh = wave >> 2, t = 16 * tt + l15;
                bf16x8 bA[2], bQ[4];
#pragma unroll
                for (int kk = 0; kk < 2; ++kk) bA[kk] = *(const LAS bf16x8*)(As + t * 72 + 8 * lq + 32 * kk);
#pragma unroll
                for (int kk = 0; kk < 4; ++kk) bQ[kk] = *(const LAS bf16x8*)(Qs + t * 136 + 8 * lq + 32 * kk);
                f32x4 o[4]; float ss = 0.f;
#pragma unroll
                for (int et = 0; et < 4; ++et) { const int e0 = 16 * (4 * eh + et);
                    f32x4 acc = {0.f, 0.f, 0.f, 0.f};
#pragma unroll
                    for (int kk = 0; kk < 2; ++kk) { const bf16x8 av = *(const LAS bf16x8*)(Vt + (e0 + l15) * 72 + 8 * ((lq + 4 * kk) ^ (((e0 >> 3) + (l15 >> 3)) & 7))); acc = __builtin_amdgcn_mfma_f32_16x16x32_bf16(av, bA[kk], acc, 0, 0, 0); }
#pragma unroll
                    for (int kk = 0; kk < 4; ++kk) { const bf16x8 as = *(const LAS bf16x8*)(St + (e0 + l15) * 136 + 8 * lq + 32 * kk); acc = __builtin_amdgcn_mfma_f32_16x16x32_bf16(as, bQ[kk], acc, 0, 0, 0); }
                    o[et] = acc; ss += (acc[0] * acc[0] + acc[1] * acc[1]) + (acc[2] * acc[2] + acc[3] * acc[3]); }
                ss += __shfl_xor(ss, 16); ss += __shfl_xor(ss, 32);
                if (lq == 0) SS[t * 2 + eh] = ss;
                __syncthreads();
                const float rs = __builtin_amdgcn_rsqf((SS[t * 2] + SS[t * 2 + 1]) * (1.0f / HD) + EPS);
#pragma unroll
                for (int et = 0; et < 4; ++et) { const int e = 16 * (4 * eh + et) + 4 * lq; const f32x4 rg = rgv[et];
                    const float y0 = o[et][0] * rs * rg[0] * bflo(gv[et].x), y1 = o[et][1] * rs * rg[1] * bfhi(gv[et].x), y2 = o[et][2] * rs * rg[2] * bflo(gv[et].y), y3 = o[et][3] * rs * rg[3] * bfhi(gv[et].y);
                    u32x2 w2; w2.x = cvt_pk_bf16(y0, y1); w2.y = cvt_pk_bf16(y2, y3);
                    *(u32x2*)(yb + (r0 + t) * D + DC + h * HD + e) = w2; }
            }
            __syncthreads();
        }
        }
    }
    SEAM(4);

    if (IN(5)) { pg8::Gemm g{yb, WoutT, M, D, D}; pg8::StaticOrder S; S.init(M, D, G, (int)blockIdx.x);
        pg8::EpiOut E{xb, ssq2, rstd1};
        pg8::gemm_phase<pg8::EpiOut, pg8::StaticOrder, true, true>(lds, g, S, E);
        { pg8::Gemm g{pb, WpleT, M, D, PLE}; pg8::StaticOrder S; S.init(M, D, G, (int)blockIdx.x);
          pg8::EpiPle E{eb, ssqE};
          pg8::gemm_phase<pg8::EpiPle, pg8::StaticOrder, true, true>(lds, g, S, E); }
    }
    SEAM(5);
    if (IN(6)) { pg8::Gemm g{xb, WupT, M, FF, D}; pg8::StaticOrder S; S.init(M, FF, G, (int)blockIdx.x);
        pg8::EpiUp E{tb};
        pg8::gemm_phase<pg8::EpiUp, pg8::StaticOrder, true, true>(lds, g, S, E); }
    SEAM(6);
    if (IN(7)) { pg8::Gemm g{tb, WdownT, M, D, FF}; pg8::StaticOrder S; S.init(M, D, G, (int)blockIdx.x);
        pg8::EpiDown E{ssq2, xb};
        pg8::gemm_phase<pg8::EpiDown, pg8::StaticOrder, true, true>(lds, g, S, E); }
    SEAM(7);
    if (IN(8)) { pg8::Gemm g{xb, WgateT, M, D, D}; pg8::StaticOrder S; S.init(M, D, G, (int)blockIdx.x);
        pg8::EpiGateFinal E{outp, xb, eb, ssqE, args.in[15], ssq3, (unsigned*)(ws + WS_PCNT), args.in[17]};
        pg8::gemm_phase<pg8::EpiGateFinal, pg8::StaticOrder, true, true>(lds, g, S, E); }
    if (DBG_TS >= 0) { xcd_barrier(bar); if (blockIdx.x == 0 && tid == 0) { if (DBG_TS == 8) tsw[1] = __builtin_amdgcn_s_memrealtime() - tsw[0]; outp[0] = 4.0f * rintf((float)tsw[1] * 0.01f * 0.25f); } }
#undef IN
#undef SEAM
}

#ifndef DBG_STOP
#define DBG_STOP -1
#endif
#ifndef DBG_OFF
#define DBG_OFF (WS_LOGF + 32 * MiB)
#endif
__global__ void dbg_dump(const unsigned short* src, float* o, int n) { for (int i = blockIdx.x * blockDim.x + threadIdx.x; i < n; i += gridDim.x * blockDim.x) o[i] = (float)src[i]; }
extern "C" void kernel_launch(void* const* d_in, const int* in_sizes, int n_in, void* d_out, int out_size, void* d_ws, size_t ws_size, hipStream_t stream) {
    static int grid = 0;
    if (grid == 0) {
        if (n_in != 18 || in_sizes[0] != M * D || out_size != M * D || ws_size < WS_END) { fprintf(stderr, "kernel_launch: unexpected shapes (n_in %d, in0 %d, out %d, ws %zu)\n", n_in, n_in > 0 ? in_sizes[0] : -1, out_size, ws_size); grid = -1; return; }
        int dev = 0, cus = 0, per_cu = 0;
        hipGetDevice(&dev); hipDeviceGetAttribute(&cus, hipDeviceAttributeMultiprocessorCount, dev);
        if (hipFuncSetAttribute((const void*)mk_fwd, hipFuncAttributeMaxDynamicSharedMemorySize, LDS_BYTES) != hipSuccess) { fprintf(stderr, "kernel_launch: hipFuncSetAttribute failed\n"); grid = -1; return; }
        if (hipOccupancyMaxActiveBlocksPerMultiprocessor(&per_cu, (const void*)mk_fwd, NTHR, LDS_BYTES) != hipSuccess || per_cu < 1) { fprintf(stderr, "kernel_launch: occupancy query says %d\n", per_cu); per_cu = 1; }
        (void)hipGetLastError();
        grid = cus;
    }
    if (grid < 0) return;
    Args a{};
    for (int i = 0; i < 18; ++i) a.in[i] = (const float*)d_in[i];
    a.out = (float*)d_out; a.ws = (unsigned char*)d_ws;
#if MK_COOP
    if (hipMemsetAsync((char*)d_ws + WS_BAR, 0, 96 * 1024, stream) != hipSuccess) { fprintf(stderr, "kernel_launch: memset of the barrier words failed\n"); return; }
    a.ph_lo = 0; a.ph_hi = N_PHASES;
    void* kargs[] = {&a};
    hipError_t e = hipLaunchCooperativeKernel((const void*)mk_fwd, dim3(grid), dim3(NTHR), kargs, LDS_BYTES, stream);
    if (e != hipSuccess) fprintf(stderr, "cooperative launch failed: %s (grid %d)\n", hipGetErrorString(e), grid);
#else
    for (int p = 0; p < N_PHASES; ++p) { if (DBG_STOP >= 0 && p > DBG_STOP) break; a.ph_lo = p; a.ph_hi = p + 1; hipLaunchKernelGGL(mk_fwd, dim3(grid), dim3(NTHR), LDS_BYTES, stream, a); }
    if (DBG_STOP >= 0) hipLaunchKernelGGL(dbg_dump, dim3(2048), dim3(256), 0, stream, (const unsigned short*)((unsigned char*)d_ws + DBG_OFF), (float*)d_out, M * D);
#endif
}
```

```cpp
#include <hip/hip_runtime.h>
#include <hip/hip_cooperative_groups.h>
#include <cstdio>
#include <cstdint>
namespace cg = cooperative_groups;
namespace pg8 {
#define PG8_LAS __attribute__((address_space(3)))
typedef unsigned short bf16_t;
typedef short bf16x8 __attribute__((ext_vector_type(8)));
typedef float f32x4 __attribute__((ext_vector_type(4)));
typedef unsigned u32x4 __attribute__((ext_vector_type(4)));
constexpr int BM = 256, BK = 64, HALF = 128, HTB = HALF * BK * 2  , STAGE_BYTES = 8 * HTB, NXCD = 8, WGM = 8;

__host__ __device__ __forceinline__ int lds_byte(int r, int c) { const int st = (r >> 4) * 2 + (c >> 5), rr = r & 15, cc = c & 31, ob = rr * 64 + cc * 2; return st * 1024 + (ob ^ (((ob >> 9) & 1) << 5)); }
__host__ __device__ __forceinline__ void stage_rc(int b, int& R, int& C) { const int st = b / 1024, sb = b % 1024, swz = sb ^ (((sb >> 9) & 1) << 5); R = (st >> 1) * 16 + swz / 64; C = (st & 1) * 32 + (swz % 64) / 2; }
__host__ __device__ __forceinline__ int perm32(int rho) { const int n = rho >> 4, i = rho & 15; return 8 * (i >> 2) + 4 * n + (i & 3); }

struct Unit { int pm, pn; };
struct Gemm { const bf16_t* A; const bf16_t* Bt; int M, N, K; };

struct StaticOrder {
    int nM, nN, nwg, G, c;
    __host__ __device__ void init(int M, int N, int G_, int c_) { nM = M / BM; nN = N / BM; nwg = nM * nN; G = G_; c = c_; }
    __host__ __device__ bool next(int i, Unit& u) const {
        const long L = (long)i * G + c; if (L >= nwg) return false;
        int wgid = (int)L; { const int q = nwg / NXCD, r = nwg % NXCD, xcd = wgid % NXCD, off = wgid / NXCD; wgid = (xcd < r ? xcd * (q + 1) : r * (q + 1) + (xcd - r) * q) + off; }
        const int nig = WGM * nN, gid = wgid / nig, fm = gid * WGM, gsz = (nM - fm) < WGM ? (nM - fm) : WGM;
        u.pm = fm + ((wgid % nig) % gsz); u.pn = (wgid % nig) / gsz; return true;
    }
    __device__ __forceinline__ void a_ready(const Unit&) const {}
    __device__ __forceinline__ void done(const Unit&) const {}
};

typedef __bf16 bf16x2_t __attribute__((ext_vector_type(2)));
typedef float f32x2_t __attribute__((ext_vector_type(2)));
__device__ __forceinline__ unsigned cvt_pk_bf16(float lo, float hi) { const f32x2_t v = {lo, hi}; const bf16x2_t b = __builtin_convertvector(v, bf16x2_t); return __builtin_bit_cast(unsigned, b); }
typedef float f32x2 __attribute__((ext_vector_type(2)));
typedef unsigned u32x2 __attribute__((ext_vector_type(2)));
__device__ __forceinline__ float sigm(float x) { return __builtin_amdgcn_rcpf(1.0f + __expf(-x)); }
__device__ __forceinline__ unsigned cvt_pk_bf16_asm(float lo, float hi) { unsigned r; asm volatile("v_cvt_pk_bf16_f32 %0, %1, %2" : "=v"(r) : "v"(lo), "v"(hi)); return r; }
__device__ __forceinline__ u32x4 pack8(const f32x4& a, const f32x4& b) { u32x4 w; w.x = cvt_pk_bf16_asm(a[0], a[1]); w.y = cvt_pk_bf16_asm(a[2], a[3]); w.z = cvt_pk_bf16_asm(b[0], b[1]); w.w = cvt_pk_bf16_asm(b[2], b[3]); return w; }
__device__ __forceinline__ u32x4 pack8v(const f32x4& a, const f32x4& b) { u32x4 w; w.x = cvt_pk_bf16(a[0], a[1]); w.y = cvt_pk_bf16(a[2], a[3]); w.z = cvt_pk_bf16(b[0], b[1]); w.w = cvt_pk_bf16(b[2], b[3]); return w; }
__device__ __forceinline__ float bflo(unsigned w) { return __uint_as_float(w << 16); }
__device__ __forceinline__ float bfhi(unsigned w) { return __uint_as_float(w & 0xffff0000u); }
constexpr float EPS_ = 1e-6f;

struct EpiIn {
    static constexpr bool PERM = true, AFTER_DRAIN = false;
    const float* rstd1; const float* lbl; bf16_t* cglu; bf16_t* qb; bf16_t* gs; _Float16* logf; bf16_t* vb;
    __device__ __forceinline__ void operator()(const f32x4 (&acc)[2][2][4][2], const Unit& u, int wr, int wc, int fr, int fq) const {
        asm volatile("s_nop 15\n\ts_nop 15" ::: "memory");
        const int kind = u.pn >> 2, j = u.pn & 3;
        const int col = j * 128 + wc * 32 + 8 * fq;
        const int row0 = u.pm * BM + wr * 64 + fr;
        if (kind == 0) {
#pragma unroll
            for (int ai = 0; ai < 2; ++ai)
#pragma unroll
                for (int m = 0; m < 4; ++m) { const int row = row0 + ai * HALF + m * 16;
                    f32x4 a0 = acc[ai][0][m][0], a1 = acc[ai][0][m][1], b0 = acc[ai][1][m][0], b1 = acc[ai][1][m][1];
#pragma unroll
                    for (int e = 0; e < 4; ++e) { a0[e] *= sigm(b0[e]); a1[e] *= sigm(b1[e]); }
                    *(u32x4*)(cglu + (size_t)row * 512 + col) = pack8(a0, a1); }
        } else if (kind == 1) {
#pragma unroll
            for (int ai = 0; ai < 2; ++ai)
#pragma unroll
                for (int m = 0; m < 4; ++m) { const int row = row0 + ai * HALF + m * 16;
                    f32x4 a0 = acc[ai][0][m][0], a1 = acc[ai][0][m][1], b0 = acc[ai][1][m][0], b1 = acc[ai][1][m][1];
#pragma unroll
                    for (int e = 0; e < 4; ++e) { b0[e] *= sigm(b0[e]); b1[e] *= sigm(b1[e]); }
                    __builtin_nontemporal_store(pack8(a0, a1), (u32x4*)(qb + (size_t)row * 512 + col));
                    __builtin_nontemporal_store(pack8(b0, b1), (u32x4*)(gs + (size_t)row * 512 + col)); }
        } else {
            float lb[8];
#pragma unroll
            for (int e = 0; e < 8; ++e) lb[e] = __builtin_amdgcn_rcpf(1.0f + __expf(lbl[512 + col + e] - lbl[col + e]));
#pragma unroll
            for (int ai = 0; ai < 2; ++ai)
#pragma unroll
                for (int m = 0; m < 4; ++m) { const int row = row0 + ai * HALF + m * 16;
                    f32x4 a0 = acc[ai][0][m][0], a1 = acc[ai][0][m][1], b0 = acc[ai][1][m][0], b1 = acc[ai][1][m][1];
#pragma unroll
                    for (int e = 0; e < 4; ++e) { a0[e] = 0.69314718056f * __builtin_amdgcn_logf(lb[e] + (1.0f - lb[e]) * sigm(a0[e])); a1[e] = 0.69314718056f * __builtin_amdgcn_logf(lb[4 + e] + (1.0f - lb[4 + e]) * sigm(a1[e])); }
                    { typedef _Float16 h2_t __attribute__((ext_vector_type(2))); u32x4 w;
                      w.x = __builtin_bit_cast(unsigned, __builtin_convertvector((f32x2_t){a0[0], a0[1]}, h2_t)); w.y = __builtin_bit_cast(unsigned, __builtin_convertvector((f32x2_t){a0[2], a0[3]}, h2_t));
                      w.z = __builtin_bit_cast(unsigned, __builtin_convertvector((f32x2_t){a1[0], a1[1]}, h2_t)); w.w = __builtin_bit_cast(unsigned, __builtin_convertvector((f32x2_t){a1[2], a1[3]}, h2_t));
                      *(u32x4*)(logf + (size_t)row * 512 + col) = w; }
                    *(u32x4*)(vb + (size_t)row * 512 + col) = pack8(b0, b1); }
        }
    }
};
struct EpiPle {
    static constexpr bool PERM = true, AFTER_DRAIN = false;
    bf16_t* e; float* ssq;
    __device__ __forceinline__ void operator()(const f32x4 (&acc)[2][2][4][2], const Unit& u, int wr, int wc, int fr, int fq) const {
        asm volatile("s_nop 15\n\ts_nop 15" ::: "memory");
        const int row0 = u.pm * BM + wr * 64 + fr, col0 = u.pn * BM + wc * 32 + 8 * fq;
#pragma unroll
        for (int ai = 0; ai < 2; ++ai)
#pragma unroll
            for (int m = 0; m < 4; ++m) { const int row = row0 + ai * HALF + m * 16; float ss = 0.f;
#pragma unroll
                for (int bj = 0; bj < 2; ++bj) { const f32x4 a0 = acc[ai][bj][m][0], a1 = acc[ai][bj][m][1];
                    __builtin_nontemporal_store(pack8(a0, a1), (u32x4*)(e + (size_t)row * 1024 + col0 + bj * HALF));
                    ss += (a0[0] * a0[0] + a0[1] * a0[1]) + (a0[2] * a0[2] + a0[3] * a0[3]) + (a1[0] * a1[0] + a1[1] * a1[1]) + (a1[2] * a1[2] + a1[3] * a1[3]); }
                ss += __shfl_xor(ss, 16); ss += __shfl_xor(ss, 32);
                if (fq == 0) __hip_atomic_fetch_add(ssq + row, ss, __ATOMIC_RELAXED, __HIP_MEMORY_SCOPE_AGENT); }
    }
};
struct EpiOut {
    static constexpr bool PERM = true, AFTER_DRAIN = false;
    bf16_t* hb; float* ssq; const float* inv1;
    __device__ __forceinline__ void operator()(const f32x4 (&acc)[2][2][4][2], const Unit& u, int wr, int wc, int fr, int fq) const {
        asm volatile("s_nop 15\n\ts_nop 15" ::: "memory");
        const int row0 = u.pm * BM + wr * 64 + fr, col0 = u.pn * BM + wc * 32 + 8 * fq;
        float iv[8];
#pragma unroll
        for (int g = 0; g < 8; ++g) iv[g] = inv1[row0 + (g >> 2) * HALF + (g & 3) * 16];
        u32x4 hq[8][2];
#define EPI_H(g_) do { _Pragma("unroll") for (int bj = 0; bj < 2; ++bj) hq[g_][bj] = *(const u32x4*)(hb + (size_t)(row0 + ((g_) >> 2) * HALF + ((g_) & 3) * 16) * 1024 + col0 + bj * HALF); } while (0)
        EPI_H(0); EPI_H(1); EPI_H(2); EPI_H(3);
        asm volatile("" ::: "memory");
#pragma unroll
        for (int g = 0; g < 8; ++g) { const int ai = g >> 2, m = g & 3; const int row = row0 + ai * HALF + m * 16; float ss = 0.f;
            if (g + 4 < 8) EPI_H(g + 4);
#pragma unroll
            for (int bj = 0; bj < 2; ++bj) { const size_t off = (size_t)row * 1024 + col0 + bj * HALF;
                const u32x4 hv = hq[g][bj];
                const f32x4 h0 = {bflo(hv.x), bfhi(hv.x), bflo(hv.y), bfhi(hv.y)}, h1 = {bflo(hv.z), bfhi(hv.z), bflo(hv.w), bfhi(hv.w)};
                const f32x4 a0 = h0 * iv[g] + acc[ai][bj][m][0], a1 = h1 * iv[g] + acc[ai][bj][m][1];
                *(u32x4*)(hb + off) = pack8(a0, a1);
                ss += (a0[0] * a0[0] + a0[1] * a0[1]) + (a0[2] * a0[2] + a0[3] * a0[3]) + (a1[0] * a1[0] + a1[1] * a1[1]) + (a1[2] * a1[2] + a1[3] * a1[3]); }
            ss += __shfl_xor(ss, 16); ss += __shfl_xor(ss, 32);
            if (fq == 0) __hip_atomic_fetch_add(ssq + row, ss, __ATOMIC_RELAXED, __HIP_MEMORY_SCOPE_AGENT);
            asm volatile("" ::: "memory"); }
#undef EPI_H
    }
};
struct EpiUp {
    static constexpr bool PERM = true, AFTER_DRAIN = false;
    bf16_t* t;
    __device__ __forceinline__ void operator()(const f32x4 (&acc)[2][2][4][2], const Unit& u, int wr, int wc, int fr, int fq) const {
        asm volatile("s_nop 15\n\ts_nop 15" ::: "memory");
        const int row0 = u.pm * BM + wr * 64 + fr, col0 = u.pn * BM + wc * 32 + 8 * fq;
#pragma unroll
        for (int ai = 0; ai < 2; ++ai)
#pragma unroll
            for (int m = 0; m < 4; ++m) { const int row = row0 + ai * HALF + m * 16;
#pragma unroll
                for (int bj = 0; bj < 2; ++bj) { f32x4 a0 = acc[ai][bj][m][0], a1 = acc[ai][bj][m][1];
#pragma unroll
                    for (int e = 0; e < 4; ++e) { const float p = fmaxf(a0[e], 0.f), q = fmaxf(a1[e], 0.f); a0[e] = p * p; a1[e] = q * q; }
                    *(u32x4*)(t + (size_t)row * 4096 + col0 + bj * HALF) = pack8(a0, a1); } }
    }
};
struct EpiDown {
    static constexpr bool PERM = true, AFTER_DRAIN = false;
    const float* ssq2; bf16_t* hb;
    __device__ __forceinline__ void operator()(const f32x4 (&acc)[2][2][4][2], const Unit& u, int wr, int wc, int fr, int fq) const {
        asm volatile("s_nop 15\n\ts_nop 15" ::: "memory");
        const int row0 = u.pm * BM + wr * 64 + fr, col0 = u.pn * BM + wc * 32 + 8 * fq;
        u32x4 hq[8][2]; float sq[8];
#pragma unroll
        for (int g = 0; g < 8; ++g) sq[g] = ssq2[row0 + (g >> 2) * HALF + (g & 3) * 16];
#define EPI_H(g_) do { _Pragma("unroll") for (int bj = 0; bj < 2; ++bj) hq[g_][bj] = *(const u32x4*)(hb + (size_t)(row0 + ((g_) >> 2) * HALF + ((g_) & 3) * 16) * 1024 + col0 + bj * HALF); } while (0)
        EPI_H(0); EPI_H(1); EPI_H(2); EPI_H(3);
        asm volatile("" ::: "memory");
#pragma unroll
        for (int g = 0; g < 8; ++g) { const int ai = g >> 2, m = g & 3; const int row = row0 + ai * HALF + m * 16; const float r2 = __builtin_amdgcn_rcpf(sq[g] * (1.0f / 1024.0f) + EPS_);
            if (g + 4 < 8) EPI_H(g + 4);
#pragma unroll
            for (int bj = 0; bj < 2; ++bj) { const size_t off = (size_t)row * 1024 + col0 + bj * HALF;
                const u32x4 hv = hq[g][bj];
                const f32x4 h0 = {bflo(hv.x), bfhi(hv.x), bflo(hv.y), bfhi(hv.y)}, h1 = {bflo(hv.z), bfhi(hv.z), bflo(hv.w), bfhi(hv.w)};
                const f32x4 a0 = h0 + acc[ai][bj][m][0] * r2, a1 = h1 + acc[ai][bj][m][1] * r2;
                *(u32x4*)(hb + off) = pack8(a0, a1); }
            asm volatile("" ::: "memory"); }
#undef EPI_H
    }
};
struct EpiGateFinal {
    static constexpr bool PERM = true, AFTER_DRAIN = false;
    float* out; const bf16_t* hb; const bf16_t* e; const float* ssqE; const float* gple; float* ssq3; unsigned* cnt; const float* gfin;
    __device__ __forceinline__ void operator()(f32x4 (&acc)[2][2][4][2], const Unit& u, int wr, int wc, int fr, int fq) const {
        asm volatile("s_nop 15\n\ts_nop 15" ::: "memory");
        const int row0 = u.pm * BM + wr * 64 + fr, col0 = u.pn * BM + wc * 32 + 8 * fq;
        {
        u32x4 hq[8][2], eq[8][2]; float sq[8];
#define EGF_E(g_) do { _Pragma("unroll") for (int bj = 0; bj < 2; ++bj) eq[g_][bj] = __builtin_nontemporal_load((const u32x4*)(e + (size_t)(row0 + ((g_) >> 2) * HALF + ((g_) & 3) * 16) * 1024 + col0 + bj * HALF)); } while (0)
#pragma unroll
        for (int g = 0; g < 8; ++g) sq[g] = ssqE[row0 + (g >> 2) * HALF + (g & 3) * 16];
#define EGF_H(g_) do { _Pragma("unroll") for (int bj = 0; bj < 2; ++bj) hq[g_][bj] = *(const u32x4*)(hb + (size_t)(row0 + ((g_) >> 2) * HALF + ((g_) & 3) * 16) * 1024 + col0 + bj * HALF); } while (0)
        EGF_H(0); EGF_E(0); EGF_H(1); EGF_E(1);
        f32x4 gp[2][2];
#pragma unroll
        for (int bj = 0; bj < 2; ++bj) { gp[bj][0] = *(const f32x4*)(gple + col0 + bj * HALF); gp[bj][1] = *(const f32x4*)(gple + col0 + bj * HALF + 4); }
        asm volatile("" ::: "memory");
#pragma unroll
        for (int g = 0; g < 8; ++g) { const int ai = g >> 2, m = g & 3; const int row = row0 + ai * HALF + m * 16; const float rE = __builtin_amdgcn_rsqf(sq[g] * (1.0f / 1024.0f) + EPS_); float ss = 0.f;
            if (g + 2 < 8) { EGF_H(g + 2); EGF_E(g + 2); }
#pragma unroll
            for (int bj = 0; bj < 2; ++bj) {
                const u32x4 ev = eq[g][bj];
                f32x4 e0 = {bflo(ev.x), bfhi(ev.x), bflo(ev.y), bfhi(ev.y)}, e1 = {bflo(ev.z), bfhi(ev.z), bflo(ev.w), bfhi(ev.w)};
                f32x4 s0 = acc[ai][bj][m][0], s1 = acc[ai][bj][m][1];
#pragma unroll
                for (int k = 0; k < 4; ++k) { s0[k] = sigm(s0[k]); s1[k] = sigm(s1[k]); }
                const u32x4 hv = hq[g][bj];
                const f32x4 h0 = {bflo(hv.x), bfhi(hv.x), bflo(hv.y), bfhi(hv.y)}, h1 = {bflo(hv.z), bfhi(hv.z), bflo(hv.w), bfhi(hv.w)};
                const f32x4 a0 = h0 + e0 * rE * gp[bj][0] * s0, a1 = h1 + e1 * rE * gp[bj][1] * s1;
                acc[ai][bj][m][0] = a0; acc[ai][bj][m][1] = a1;
                ss += (a0[0] * a0[0] + a0[1] * a0[1]) + (a0[2] * a0[2] + a0[3] * a0[3]) + (a1[0] * a1[0] + a1[1] * a1[1]) + (a1[2] * a1[2] + a1[3] * a1[3]); }
            ss += __shfl_xor(ss, 16); ss += __shfl_xor(ss, 32);
            if (fq == 0) __hip_atomic_fetch_add(ssq3 + row, ss, __ATOMIC_RELAXED, __HIP_MEMORY_SCOPE_AGENT);
            asm volatile("" ::: "memory"); }
#undef EGF_E
#undef EGF_H
        }
        asm volatile("s_waitcnt vmcnt(0)" ::: "memory");
        unsigned* pc = cnt + 64 * u.pm;
        if ((threadIdx.x & 63) == 0) __hip_atomic_fetch_add(pc, 1u, __ATOMIC_RELAXED, __HIP_MEMORY_SCOPE_AGENT);
        { unsigned sp = 0;
          while ((unsigned)__builtin_amdgcn_readfirstlane(__hip_atomic_load(pc, __ATOMIC_RELAXED, __HIP_MEMORY_SCOPE_AGENT)) < 32u) { __builtin_amdgcn_s_sleep(2); if (++sp > (1u << 22)) break; } }
        __builtin_amdgcn_fence(__ATOMIC_ACQUIRE, "agent");
        float s3[8];
#pragma unroll
        for (int g = 0; g < 8; ++g) s3[g] = __hip_atomic_load(ssq3 + row0 + (g >> 2) * HALF + (g & 3) * 16, __ATOMIC_RELAXED, __HIP_MEMORY_SCOPE_AGENT);
        f32x4 gf[2][2];
#pragma unroll
        for (int bj = 0; bj < 2; ++bj) { gf[bj][0] = *(const f32x4*)(gfin + col0 + bj * HALF); gf[bj][1] = *(const f32x4*)(gfin + col0 + bj * HALF + 4); }
#pragma unroll
        for (int ai = 0; ai < 2; ++ai)
#pragma unroll
            for (int m = 0; m < 4; ++m) { const int row = row0 + ai * HALF + m * 16;
                const float rs = __builtin_amdgcn_rsqf(s3[ai * 4 + m] * (1.0f / 1024.0f) + EPS_);
#pragma unroll
                for (int bj = 0; bj < 2; ++bj) { const size_t off = (size_t)row * 1024 + col0 + bj * HALF;
                    *(f32x4*)(out + off) = acc[ai][bj][m][0] * rs * gf[bj][0]; *(f32x4*)(out + off + 4) = acc[ai][bj][m][1] * rs * gf[bj][1]; }
                asm volatile("" ::: "memory"); }
    }
};

template <class Epi, class Sched, bool ALIGN_EPI = false, bool SP2 = false>
__device__ __forceinline__ void gemm_phase(PG8_LAS unsigned char* lds, const Gemm g, const Sched& S, const Epi& E) {
    const int tid = threadIdx.x, wid = __builtin_amdgcn_readfirstlane(tid >> 6), lane = tid & 63, wr = wid >> 2, wc = wid & 3, fr = lane & 15, fq = lane >> 4;
    const int K = g.K, nt = K / BK;
    unsigned voffA[2], voffB[2];
#pragma unroll
    for (int i = 0; i < 2; ++i) { int R, C; stage_rc(tid * 16 + i * 8192, R, C); const int Rb = Epi::PERM ? ((R & ~31) + perm32(R & 31)) : R;
        voffA[i] = (unsigned)(R * K + C) * 2u; voffB[i] = (unsigned)(Rb * K + C) * 2u; }
    const size_t kstep = (size_t)(BK * 2);
    const size_t hstep = (size_t)HALF * K * 2;
    const size_t tstep = 2 * hstep;
    const unsigned ldsw = (unsigned)wid * 1024u;
    const int aoff = lds_byte(wr * 64 + fr, fq * 8), boff = lds_byte(wc * 32 + fr, fq * 8);
#define PG8_SA(b, h) (((b) * 2 + (h)) * HTB)
#define PG8_SB(b, h) ((4 + (b) * 2 + (h)) * HTB)
#define PG8_STAGE(bufoff, gbase, voff) do { _Pragma("unroll") for (int _i = 0; _i < 2; ++_i) \
        __builtin_amdgcn_global_load_lds((const unsigned*)((const char*)(gbase) + (voff)[_i]), (PG8_LAS unsigned*)(lds + (bufoff) + ldsw + _i * 8192), 16, 0, 0); } while (0)
#define PG8_LDA(dst, b, h) do { _Pragma("unroll") for (int m = 0; m < 4; ++m) _Pragma("unroll") for (int k = 0; k < 2; ++k) dst[m][k] = *(const PG8_LAS bf16x8*)(lds + PG8_SA(b, h) + aoff + m * 2048 + k * 1024); } while (0)
#define PG8_LDB(dst, b, h) do { _Pragma("unroll") for (int n = 0; n < 2; ++n) _Pragma("unroll") for (int k = 0; k < 2; ++k) dst[n][k] = *(const PG8_LAS bf16x8*)(lds + PG8_SB(b, h) + boff + n * 2048 + k * 1024); } while (0)
#define PG8_MMA(ai, bj, At, Bt) do { __builtin_amdgcn_s_setprio(1); _Pragma("unroll") for (int m = 0; m < 4; ++m) _Pragma("unroll") for (int n = 0; n < 2; ++n) _Pragma("unroll") for (int k = 0; k < 2; ++k) \
        acc[ai][bj][m][n] = __builtin_amdgcn_mfma_f32_16x16x32_bf16(Bt[n][k], At[m][k], acc[ai][bj][m][n], 0, 0, 0); __builtin_amdgcn_s_setprio(0); } while (0)
#define PG8_WAIT_V(n) asm volatile("s_waitcnt vmcnt(" #n ")" ::: "memory")
#define PG8_WAIT_L(n) asm volatile("s_waitcnt lgkmcnt(" #n ")" ::: "memory")
#define PG8_BAR __builtin_amdgcn_s_barrier()
#define PG8_SCHED __builtin_amdgcn_sched_barrier(0)
    Unit cur, nxt; int ui = 0;
    if (!S.next(0, cur)) return;
    f32x4 acc[2][2][4][2];
#pragma unroll
    for (int a = 0; a < 2; ++a)
#pragma unroll
        for (int b = 0; b < 2; ++b)
#pragma unroll
            for (int m = 0; m < 4; ++m)
#pragma unroll
                for (int n = 0; n < 2; ++n) acc[a][b][m][n] = (f32x4){0.f, 0.f, 0.f, 0.f};
    bf16x8 At[4][2], B0[2][2], B1[2][2];
    const char* cA = (const char*)g.A + (size_t)cur.pm * tstep; const char* cB = (const char*)g.Bt + (size_t)cur.pn * tstep;
    S.a_ready(cur);
    if constexpr (SP2) {
        PG8_STAGE(PG8_SB(0, 0), cB, voffB); PG8_STAGE(PG8_SB(0, 1), cB + hstep, voffB); PG8_STAGE(PG8_SA(0, 0), cA, voffA); PG8_STAGE(PG8_SA(0, 1), cA + hstep, voffA);
        if (wr == 1) PG8_BAR;
        PG8_WAIT_V(2); PG8_BAR;
        PG8_STAGE(PG8_SB(1, 0), cB + kstep, voffB); PG8_STAGE(PG8_SA(1, 0), cA + kstep, voffA); PG8_STAGE(PG8_SB(1, 1), cB + hstep + kstep, voffB);
        PG8_WAIT_V(6); PG8_BAR;
    } else {
        PG8_STAGE(PG8_SB(0, 0), cB, voffB); PG8_STAGE(PG8_SA(0, 0), cA, voffA); PG8_STAGE(PG8_SB(0, 1), cB + hstep, voffB); PG8_STAGE(PG8_SA(0, 1), cA + hstep, voffA);
        if (wr == 1) PG8_BAR;
        PG8_WAIT_V(4); PG8_BAR;
        PG8_STAGE(PG8_SB(1, 0), cB + kstep, voffB); PG8_STAGE(PG8_SA(1, 0), cA + kstep, voffA); PG8_STAGE(PG8_SB(1, 1), cB + hstep + kstep, voffB);
        PG8_WAIT_V(6); PG8_BAR;
    }
    for (;;) {
        const bool has_next = S.next(ui + 1, nxt);
        const char* nA = has_next ? (const char*)g.A + (size_t)nxt.pm * tstep : cA; const char* nB = has_next ? (const char*)g.Bt + (size_t)nxt.pn * tstep : cB;
        for (int t = 0; t < nt; t += 2) {
            const bool last = (t == nt - 2);
            const char* a1 = cA + (size_t)(t + 1) * kstep;
            const char* a2 = last ? nA : cA + (size_t)(t + 2) * kstep; const char* b2 = last ? nB : cB + (size_t)(t + 2) * kstep;
            const char* a3 = a2 + kstep; const char* b3 = b2 + kstep;
            if (last && has_next) S.a_ready(nxt);
            if constexpr (SP2) {
            PG8_LDB(B0, 0, 0); PG8_LDB(B1, 0, 1); PG8_SCHED; PG8_LDA(At, 0, 0); PG8_STAGE(PG8_SA(1, 1), a1 + hstep, voffA);
            PG8_WAIT_V(8); PG8_WAIT_L(0); PG8_BAR; PG8_MMA(0, 0, At, B0); PG8_MMA(0, 1, At, B1); PG8_BAR; PG8_SCHED;
            PG8_LDA(At, 0, 1); PG8_STAGE(PG8_SB(0, 0), b2, voffB); PG8_STAGE(PG8_SB(0, 1), b2 + hstep, voffB); PG8_STAGE(PG8_SA(0, 0), a2, voffA);
            PG8_WAIT_V(8); PG8_WAIT_L(0); PG8_BAR; PG8_MMA(1, 0, At, B0); PG8_MMA(1, 1, At, B1); PG8_BAR; PG8_SCHED;
            PG8_LDB(B0, 1, 0); PG8_LDB(B1, 1, 1); PG8_SCHED; PG8_LDA(At, 1, 0); PG8_STAGE(PG8_SA(0, 1), a2 + hstep, voffA);
            PG8_WAIT_V(8); PG8_WAIT_L(0); PG8_BAR; PG8_MMA(0, 0, At, B0); PG8_MMA(0, 1, At, B1); PG8_BAR; PG8_SCHED;
            PG8_LDA(At, 1, 1); PG8_STAGE(PG8_SB(1, 0), b3, voffB); PG8_STAGE(PG8_SB(1, 1), b3 + hstep, voffB); PG8_STAGE(PG8_SA(1, 0), a3, voffA);
            PG8_WAIT_V(8); PG8_WAIT_L(0); PG8_BAR; PG8_MMA(1, 0, At, B0); PG8_MMA(1, 1, At, B1); PG8_BAR; PG8_SCHED;
            } else {
            PG8_LDB(B0, 0, 0); PG8_SCHED; PG8_LDA(At, 0, 0); PG8_STAGE(PG8_SA(1, 1), a1 + hstep, voffA);
            PG8_WAIT_L(8); PG8_BAR; PG8_WAIT_L(0); PG8_MMA(0, 0, At, B0); PG8_BAR; PG8_SCHED;
            PG8_LDB(B1, 0, 1); PG8_STAGE(PG8_SB(0, 0), b2, voffB);
            PG8_BAR; PG8_WAIT_L(0); PG8_MMA(0, 1, At, B1); PG8_BAR;
            PG8_LDA(At, 0, 1); PG8_STAGE(PG8_SA(0, 0), a2, voffA);
            PG8_BAR; PG8_WAIT_L(0); PG8_MMA(1, 0, At, B0); PG8_BAR; PG8_SCHED;
            PG8_STAGE(PG8_SB(0, 1), b2 + hstep, voffB);
            PG8_WAIT_V(6); PG8_BAR; PG8_MMA(1, 1, At, B1); PG8_BAR;
            PG8_LDB(B0, 1, 0); PG8_SCHED; PG8_LDA(At, 1, 0); PG8_STAGE(PG8_SA(0, 1), a2 + hstep, voffA);
            PG8_WAIT_L(8); PG8_BAR; PG8_WAIT_L(0); PG8_MMA(0, 0, At, B0); PG8_BAR; PG8_SCHED;
            PG8_LDB(B1, 1, 1); PG8_STAGE(PG8_SB(1, 0), b3, voffB);
            PG8_BAR; PG8_WAIT_L(0); PG8_MMA(0, 1, At, B1); PG8_BAR;
            PG8_LDA(At, 1, 1); PG8_STAGE(PG8_SA(1, 0), a3, voffA);
            PG8_BAR; PG8_WAIT_L(0); PG8_MMA(1, 0, At, B0); PG8_BAR; PG8_SCHED;
            PG8_STAGE(PG8_SB(1, 1), b3 + hstep, voffB);
            PG8_WAIT_V(6); PG8_BAR; PG8_MMA(1, 1, At, B1); PG8_BAR;
            }
        }
        if constexpr (ALIGN_EPI) { if (wr == 0) PG8_BAR; }
        if constexpr (!Epi::AFTER_DRAIN) { E(acc, cur, wr, wc, fr, fq); S.done(cur); }
        if (!has_next) break;
#pragma unroll
        for (int a = 0; a < 2; ++a)
#pragma unroll
            for (int b = 0; b < 2; ++b)
#pragma unroll
                for (int m = 0; m < 4; ++m)
#pragma unroll
                    for (int n = 0; n < 2; ++n) acc[a][b][m][n] = (f32x4){0.f, 0.f, 0.f, 0.f};
        cur = nxt; cA = nA; cB = nB; ++ui;
        if constexpr (ALIGN_EPI) { if (wr == 1) PG8_BAR; }
    }
    PG8_WAIT_V(0);
    if constexpr (!ALIGN_EPI) { if (wr == 0) PG8_BAR; }
    PG8_BAR;
    if constexpr (Epi::AFTER_DRAIN) { E.fused(acc, cur, wr, wc, fr, fq, lds, wid, lane); S.done(cur); }
#undef PG8_SA
#undef PG8_SB
#undef PG8_STAGE
#undef PG8_LDA
#undef PG8_LDB
#undef PG8_MMA
#undef PG8_WAIT_V
#undef PG8_WAIT_L
#undef PG8_BAR
#undef PG8_SCHED
}
}

#define LAS __attribute__((address_space(3)))
typedef unsigned short bf16_t;
typedef short bf16x8 __attribute__((ext_vector_type(8)));
typedef float f32x4 __attribute__((ext_vector_type(4)));
typedef unsigned u32x4 __attribute__((ext_vector_type(4)));
typedef unsigned u32x2 __attribute__((ext_vector_type(2)));
using pg8::cvt_pk_bf16; using pg8::bflo; using pg8::bfhi; using pg8::sigm; using pg8::f32x2_t;

#ifndef MK_COOP
#define MK_COOP 1
#endif
constexpr int NWAVES = 8, NTHR = 512;
constexpr int BATCH = 8, SEQ = 4096, D = 1024, M = BATCH * SEQ, DIN = 3072, FF = 4096, PLE = 256, DC = 512, DR = 512, NH = 4, HD = 128, CH = 64, NCHUNK = SEQ / CH;
constexpr int NUNIT = BATCH * NH * NCHUNK;
constexpr float EPS = 1e-6f;
constexpr int N_PHASES = 9;
constexpr size_t MiB = 1u << 20;
constexpr size_t WS_PCNT = 576 * 1024;
constexpr size_t WS_BAR = 512 * 1024;
constexpr size_t WS_RSTD1 = 0, WS_SSQ2 = 128 * 1024, WS_SSQE = 256 * 1024, WS_SSQ3 = 384 * 1024, WS_DEC = 1 * MiB;
constexpr size_t WS_WIN = 2 * MiB, WS_WOUT = 8 * MiB, WS_WUP = 10 * MiB, WS_WDOWN = 18 * MiB, WS_WPLE = 26 * MiB, WS_WGATE = 27 * MiB;
constexpr size_t WS_XB = 32 * MiB;
constexpr size_t WS_PB = 96 * MiB;
constexpr size_t WS_CGLU = 112 * MiB, WS_QB = 144 * MiB, WS_GS = 176 * MiB, WS_LOGF = 208 * MiB, WS_VB = 272 * MiB, WS_UT = 304 * MiB;
constexpr size_t WS_T = 112 * MiB;
constexpr size_t WS_Y = 368 * MiB;
constexpr size_t WS_E = 432 * MiB;
constexpr size_t WS_ASEG = 496 * MiB, WS_ESEG = 504 * MiB;
constexpr size_t WS_DSEG = 29 * MiB;
constexpr size_t WS_END = 512 * MiB;
constexpr int LDS_BYTES = 147456;

__device__ __forceinline__ float wave_sum(float v) {
#pragma unroll
    for (int o = 1; o < 64; o <<= 1) v += __shfl_xor(v, o);
    return v;
}
#define LDS_WAIT() asm volatile("s_waitcnt lgkmcnt(0)" ::: "memory")

__device__ __forceinline__ void transpose_item(const float* W, int K, int N, bf16_t* WT, int mode, const float* gain, LAS float* scr, int item, int lane) {
    const int nblk = N / 32, kb = item / nblk, nb = item % nblk, k0 = 64 * kb, n0 = 32 * nb;
#pragma unroll 8
    for (int i = 0; i < 32; ++i) { const int kk = 2 * i + (lane >> 5); float w = __builtin_nontemporal_load(W + (size_t)(k0 + kk) * N + n0 + (lane & 31)); if (gain) w *= gain[k0 + kk]; scr[kk * 33 + (lane & 31)] = w; }
    LDS_WAIT();
    int drow0 = n0;
    if (mode == 1) { const int region = n0 >> 9, within = n0 & 511, j = within >> 7, c0 = within & 127;
        int tile, bj;
        switch (region) { case 0: tile = j; bj = 0; break; case 1: tile = j; bj = 1; break; case 2: tile = 4 + j; bj = 0; break;
                          case 3: tile = 8 + j; bj = 0; break; case 4: tile = 8 + j; bj = 1; break; default: tile = 4 + j; bj = 1; break; }
        drow0 = tile * 256 + bj * 128 + c0; }
    const int c = lane & 7;
#pragma unroll
    for (int j = 0; j < 4; ++j) { const int n = (lane >> 3) + 8 * j; const LAS float* s = scr + (8 * c) * 33 + n;
        u32x4 o; o.x = cvt_pk_bf16(s[0 * 33], s[1 * 33]); o.y = cvt_pk_bf16(s[2 * 33], s[3 * 33]); o.z = cvt_pk_bf16(s[4 * 33], s[5 * 33]); o.w = cvt_pk_bf16(s[6 * 33], s[7 * 33]);
        *(u32x4*)(WT + (size_t)(drow0 + n) * K + k0 + 8 * c) = o; }
    LDS_WAIT();
}

typedef __attribute__((address_space(1))) unsigned gu32;
#define XB_TMO      128
#define XB_XCNT(j)  (256  + 64 * (j))
#define XB_XSUB(j)  (1280 + 64 * (j))
#define XB_XGEN(j)  (2304 + 64 * (j))
#define XB_TOP      3328
#define XB_TOPGEN   3392
#define XCD_BAR_WORDS 3456
#define XB_SPIN_CAP (1u << 18)

__device__ __forceinline__ unsigned xb_ld(unsigned* p)              { return __hip_atomic_load(p, __ATOMIC_RELAXED, __HIP_MEMORY_SCOPE_AGENT); }
__device__ __forceinline__ unsigned xb_add(unsigned* p, unsigned v) { return __hip_atomic_fetch_add(p, v, __ATOMIC_RELAXED, __HIP_MEMORY_SCOPE_AGENT); }
__device__ __forceinline__ unsigned xb_xcc_id() { return (unsigned)__builtin_amdgcn_s_getreg((3 << 11) | 20) & 0xFu; }
#define XB_SPIN(cond, bar) do { unsigned _sp = 0; while (cond) { __builtin_amdgcn_s_sleep(1); \
    if ((++_sp & 255u) == 0u) { if (xb_ld(&(bar)[XB_TMO])) break; if (_sp > XB_SPIN_CAP) { atomicAdd(&(bar)[XB_TMO], 1u); break; } } } } while (0)

struct XcdBarrier {
    unsigned* bar; unsigned x;
    volatile LAS unsigned* st;
};

__device__ __forceinline__ XcdBarrier xcd_barrier_post(unsigned* bar, volatile LAS unsigned* st) {
    XcdBarrier b; b.bar = bar; b.x = xb_xcc_id(); b.st = st;
    if (threadIdx.x == 0) (void)xb_add(&bar[XB_XCNT(b.x)], 1u);
    return b;
}
__device__ __forceinline__ void xcd_barrier_complete(unsigned* bar, unsigned x, unsigned& nloc, unsigned& nx) {
    const unsigned G = gridDim.x * gridDim.y * gridDim.z;
    unsigned sum, cnt, mine, sp = 0u;
    for (;;) {
        sum = 0u; cnt = 0u; mine = 0u;
#pragma unroll
        for (unsigned j = 0; j < 16; ++j) { const unsigned c = xb_ld(&bar[XB_XCNT(j)]); sum += c; cnt += (c > 0u) ? 1u : 0u; mine = (j == x) ? c : mine; }
        if (sum == G) break;
        __builtin_amdgcn_s_sleep(1);
        if ((++sp & 255u) == 0u) { if (xb_ld(&bar[XB_TMO])) break; if (sp > XB_SPIN_CAP) { atomicAdd(&bar[XB_TMO], 1u); break; } }
    }
    nloc = mine > 0u ? mine : 1u; nx = cnt > 0u ? cnt : 1u;
}

__device__ __forceinline__ void xcd_barrier(const XcdBarrier& b) {
    asm volatile("s_waitcnt vmcnt(0)" ::: "memory");
    __syncthreads();
    if (threadIdx.x == 0) {
        unsigned* bar = b.bar;
        __builtin_amdgcn_s_waitcnt(0);
        unsigned nloc = b.st[0], nx = b.st[1];
        if (nloc == 0u) { xcd_barrier_complete(bar, b.x, nloc, nx); b.st[0] = nloc; b.st[1] = nx; }
        const unsigned old = xb_add(&bar[XB_XSUB(b.x)], 1u);
        const unsigned gen = old / nloc;
        if (old + 1u == (gen + 1u) * nloc) {
            __builtin_amdgcn_fence(__ATOMIC_RELEASE, "agent");
            asm volatile("s_waitcnt vmcnt(0)" ::: "memory");
            const unsigned og = xb_add(&bar[XB_TOP], 1u);
            const unsigned tg = og / nx;
            if (og + 1u == (tg + 1u) * nx) xb_add(&bar[XB_TOPGEN], 1u);
            else XB_SPIN(xb_ld(&bar[XB_TOPGEN]) == tg, bar);
            __builtin_amdgcn_fence(__ATOMIC_ACQUIRE, "agent");
            xb_add(&bar[XB_XGEN(b.x)], 1u);
            asm volatile("s_waitcnt vmcnt(0)" ::: "memory");
        } else {
            XB_SPIN(xb_ld(&bar[XB_XGEN(b.x)]) == gen, bar);
            __builtin_amdgcn_fence(__ATOMIC_ACQUIRE, "agent");
            asm volatile("s_waitcnt vmcnt(0)" ::: "memory");
        }
    }
    __syncthreads();
}

struct Args { const float* in[18]; float* out; unsigned char* ws; int ph_lo, ph_hi; };

__global__ void __launch_bounds__(NTHR, 2) mk_fwd(Args args) {
    extern __shared__ __attribute__((aligned(16))) unsigned char lds_raw[];
    LAS unsigned char* lds = (LAS unsigned char*)lds_raw;
    cg::grid_group grid = cg::this_grid();
    const int tid = threadIdx.x, lane = tid & 63, wave = __builtin_amdgcn_readfirstlane(tid >> 6);
    const int G = gridDim.x, gw = blockIdx.x * NWAVES + wave, NGW = G * NWAVES;
    const int lo = args.ph_lo, hi = args.ph_hi;
    unsigned char* const ws = args.ws;
#define xin (args.in[0])
#define outp (args.out)
#define rstd1 ((float*)(ws + WS_RSTD1))
#define ssq2 ((float*)(ws + WS_SSQ2))
#define ssqE ((float*)(ws + WS_SSQE))
#define ssq3 ((float*)(ws + WS_SSQ3))
#define dec ((float*)(ws + WS_DEC))
#define WinT ((bf16_t*)(ws + WS_WIN))
#define WoutT ((bf16_t*)(ws + WS_WOUT))
#define WupT ((bf16_t*)(ws + WS_WUP))
#define WdownT ((bf16_t*)(ws + WS_WDOWN))
#define WpleT ((bf16_t*)(ws + WS_WPLE))
#define WgateT ((bf16_t*)(ws + WS_WGATE))
#define xb ((bf16_t*)(ws + WS_XB))
#define pb ((bf16_t*)(ws + WS_PB))
#define cglu ((bf16_t*)(ws + WS_CGLU))
#define qb ((bf16_t*)(ws + WS_QB))
#define gs ((bf16_t*)(ws + WS_GS))
#define logf ((_Float16*)(ws + WS_LOGF))
#define vb ((bf16_t*)(ws + WS_VB))
#define Ut ((bf16_t*)(ws + WS_UT))
#define tb ((bf16_t*)(ws + WS_T))
#define yb ((bf16_t*)(ws + WS_Y))
#define eb ((bf16_t*)(ws + WS_E))
#define Aseg ((bf16_t*)(ws + WS_ASEG))
#define Eseg ((bf16_t*)(ws + WS_ESEG))
#define Dseg ((float*)(ws + WS_DSEG))
#define IN(k) (lo <= (k) && (k) < hi)
#ifndef DBG_TS
#define DBG_TS -1
#endif
    volatile LAS unsigned* bar_st = (volatile LAS unsigned*)(lds + 147328 + 64);
    if (tid < 2) bar_st[tid] = 0u;
    __syncthreads();
    XcdBarrier bar; bar.bar = (unsigned*)(ws + WS_BAR); bar.x = 0; bar.st = bar_st;
    if (hi - lo > 1) bar = xcd_barrier_post((unsigned*)(ws + WS_BAR), bar_st);
    volatile LAS unsigned long long* tsw = (volatile LAS unsigned long long*)(lds + 147328);
    if (DBG_TS >= 0 && tid == 0) { tsw[0] = __builtin_amdgcn_s_memrealtime(); tsw[1] = 0ull; }
#define SEAM(k) do { if (IN(k) && IN((k) + 1)) { if (hi > N_PHASES) grid.sync(); else xcd_barrier(bar); } if (DBG_TS >= 0 && tid == 0) { const unsigned long long t_ = __builtin_amdgcn_s_memrealtime(); if ((k) == DBG_TS) tsw[1] = t_ - tsw[0]; tsw[0] = t_; } } while (0)

#define TSMARK(id) do { if (DBG_TS == (id) && tid == 0) tsw[1] = __builtin_amdgcn_s_memrealtime() - tsw[0]; } while (0)
    if (IN(0)) {
        LAS float* scr = (LAS float*)(lds + wave * 16384);
        constexpr int I_IN = (D / 64) * (DIN / 32);
        for (int it = gw; it < I_IN; it += NGW) transpose_item(args.in[3], D, DIN, WinT, 1, args.in[2], scr, it, lane);
        for (int m0 = gw; m0 < M; m0 += 2 * NGW) {
            f32x4 v[2][4];
#pragma unroll
            for (int r = 0; r < 2; ++r) { const int m = m0 + r * NGW; const f32x4* xr = (const f32x4*)(xin + (size_t)m * D) + lane;
#pragma unroll
                for (int j = 0; j < 4; ++j) v[r][j] = __builtin_nontemporal_load(xr + 64 * j); }
#pragma unroll
            for (int r = 0; r < 2; ++r) { const int m = m0 + r * NGW; float sq = 0.f;
#pragma unroll
                for (int j = 0; j < 4; ++j) sq += (v[r][j][0] * v[r][j][0] + v[r][j][1] * v[r][j][1]) + (v[r][j][2] * v[r][j][2] + v[r][j][3] * v[r][j][3]);
                sq = wave_sum(sq);
                if (lane == 0) rstd1[m] = sqrtf(sq * (1.0f / D) + EPS);
                u32x2* o8 = (u32x2*)(xb + (size_t)m * D) + lane;
                const float rs_ = __builtin_amdgcn_rsqf(sq * (1.0f / D) + EPS);
#pragma unroll
                for (int j = 0; j < 4; ++j) { u32x2 w; w.x = cvt_pk_bf16(v[r][j][0] * rs_, v[r][j][1] * rs_); w.y = cvt_pk_bf16(v[r][j][2] * rs_, v[r][j][3] * rs_); o8[64 * j] = w; } }
        }
        for (int i = blockIdx.x * NTHR + tid; i < M; i += G * NTHR) { ssq2[i] = 0.f; ssqE[i] = 0.f; ssq3[i] = 0.f; }
        __syncthreads();
    }
    SEAM(0);

    if (IN(1)) {
        { pg8::Gemm g{xb, WinT, M, DIN, D}; pg8::StaticOrder S; S.init(M, DIN, G, (int)blockIdx.x);
          pg8::EpiIn E{rstd1, args.in[8], cglu, qb, gs, logf, vb};
          pg8::gemm_phase<pg8::EpiIn, pg8::StaticOrder, true, true>(lds, g, S, E); }
    }
    SEAM(1);

    if (IN(2)) {
        {
            LAS float* scr = (LAS float*)(lds + wave * 15872);
            constexpr int I_OUT = (D / 64) * (D / 32), I_UP = (D / 64) * (FF / 32), I_DOWN = (FF / 64) * (D / 32), I_PLE = (PLE / 64) * (D / 32), I_GATE = I_OUT;
            constexpr int NIT2 = I_OUT + I_UP + I_DOWN + I_PLE + I_GATE;
            for (int it = gw; it < NIT2; it += NGW) {
                int r = it;
                if (r < I_OUT) { transpose_item(args.in[10], D, D, WoutT, 0, nullptr, scr, r, lane); continue; } r -= I_OUT;
                if (r < I_UP) { transpose_item(args.in[12], D, FF, WupT, 0, args.in[11], scr, r, lane); continue; } r -= I_UP;
                if (r < I_DOWN) { transpose_item(args.in[13], FF, D, WdownT, 0, nullptr, scr, r, lane); continue; } r -= I_DOWN;
                if (r < I_PLE) { transpose_item(args.in[14], PLE, D, WpleT, 0, nullptr, scr, r, lane); continue; } r -= I_PLE;
                transpose_item(args.in[16], D, D, WgateT, 0, nullptr, scr, r, lane);
            }
            for (int m0 = gw; m0 < M; m0 += 4 * NGW) {
                f32x4 pv[4];
#pragma unroll
                for (int r = 0; r < 4; ++r) pv[r] = __builtin_nontemporal_load((const f32x4*)(args.in[1] + (size_t)(m0 + r * NGW) * PLE) + lane);
#pragma unroll
                for (int r = 0; r < 4; ++r) { u32x2 w; w.x = cvt_pk_bf16(pv[r][0], pv[r][1]); w.y = cvt_pk_bf16(pv[r][2], pv[r][3]); *((u32x2*)(pb + (size_t)(m0 + r * NGW) * PLE) + lane) = w; }
            }
        }
        {
            typedef float f32x2 __attribute__((ext_vector_type(2)));
            LAS bf16_t* Xs = (LAS bf16_t*)(lds + wave * 15872);
            const float* cw = args.in[4]; const float* cbias = args.in[5]; const float* lng = args.in[6]; const float* lnb = args.in[7];
            for (int uidx = gw; uidx < (M / 32) * 4; uidx += NGW) {
                const int tile = uidx >> 2, cb = uidx & 3, b = tile >> 7, t0 = (tile & 127) * 32;
                const int rr = lane >> 4, c16 = lane & 15;
#pragma unroll 4
                for (int it = 0; it < 16; ++it) { const int i = it * 4 + rr; const int t = t0 - 30 + i;
                    if (i < 62) { u32x4 v = {0u, 0u, 0u, 0u}; if (t >= 0) v = __builtin_nontemporal_load((const u32x4*)(cglu + ((size_t)b * SEQ + t) * DC + cb * 128 + c16 * 8));
                        *(LAS u32x4*)(Xs + i * 128 + c16 * 8) = v; } }
                const int ch = cb * 128 + 2 * lane;
                f32x2 wj[31];
#pragma unroll
                for (int j = 0; j < 31; ++j) wj[j] = *(const f32x2*)(cw + j * DC + ch);
                const f32x2 bias = *(const f32x2*)(cbias + ch), gg = *(const f32x2*)(lng + ch), bb = *(const f32x2*)(lnb + ch);
                LDS_WAIT();
                for (int tblk = 0; tblk < 8; ++tblk) {
                    f32x2 xs[34];
#pragma unroll
                    for (int i = 0; i < 34; ++i) { const unsigned w = *(const LAS unsigned*)(Xs + (tblk * 4 + i) * 128 + 2 * lane); xs[i] = (f32x2){bflo(w), bfhi(w)}; }
                    f32x2 av[4]; float s1[4], s2[4];
#pragma unroll
                    for (int o = 0; o < 4; ++o) { f32x2 a = bias;
#pragma unroll
                        for (int j = 0; j < 31; ++j) a = __builtin_elementwise_fma(wj[j], xs[o + j], a);
                        av[o] = a; s1[o] = a.x + a.y; s2[o] = a.x * a.x + a.y * a.y; }
#pragma unroll
                    for (int st = 1; st < 32; st <<= 1) {
#pragma unroll
                        for (int o = 0; o < 4; ++o) { s1[o] += __shfl_xor(s1[o], st); s2[o] += __shfl_xor(s2[o], st); } }
#pragma unroll
                    for (int o = 0; o < 4; ++o) { const float mu = s1[o] * (1.0f / 64.0f); const float var = fmaxf(s2[o] * (1.0f / 64.0f) - mu * mu, 0.f);
                        const float rs = __builtin_amdgcn_rsqf(var + EPS);
                        f32x2 yv = (av[o] - mu) * rs * gg + bb; yv.x = yv.x * sigm(yv.x); yv.y = yv.y * sigm(yv.y);
                        *(unsigned*)(yb + ((size_t)b * SEQ + t0 + tblk * 4 + o) * D + ch) = cvt_pk_bf16(yv.x, yv.y); }
                }
                LDS_WAIT();
            }
        }
        __syncthreads();
        {
            LAS bf16_t* Kt = (LAS bf16_t*)(lds);
            LAS bf16_t* Vt = (LAS bf16_t*)(lds + 18432);
            LAS float* PT = (LAS float*)(lds + 57344);
            LAS float* DEC = (LAS float*)(lds + 38912);
            LAS _Float16* RawLF = (LAS _Float16*)(lds + 40960);
            const int dp = tid & 63, part = tid >> 6, l15 = lane & 15, lq = lane >> 4;
            typedef _Float16 h2v __attribute__((ext_vector_type(2)));
            u32x4 lfr[2], vvn[2];
#define H1_LOAD(unit_) do { const int c_ = (unit_) & 63, bh_ = (unit_) >> 6, h_ = bh_ & 3, b_ = bh_ >> 2; const size_t r0_ = (size_t)b_ * SEQ + 64 * c_; \
                _Pragma("unroll") for (int it = 0; it < 2; ++it) { const int idx = tid + 512 * it; lfr[it] = *(const u32x4*)(logf + (r0_ + (idx >> 4)) * DR + h_ * HD + (idx & 15) * 8); } \
                _Pragma("unroll") for (int it = 0; it < 2; ++it) { const int idx = tid + 512 * it, s = idx >> 4, e8 = idx & 15; vvn[it] = *(const u32x4*)(vb + (r0_ + s) * DR + h_ * HD + e8 * 8); } } while (0)
            const int segid = (int)blockIdx.x;
            const int unit0 = ((segid >> 3) << 6) | ((segid & 7) << 3);
            f32x4 Srun[8];
#pragma unroll
            for (int et = 0; et < 8; ++et) Srun[et] = (f32x4){0.f, 0.f, 0.f, 0.f};
            float dpre0 = 1.0f, dpre1 = 1.0f;
            const int d0 = 16 * wave;
            if (segid < BATCH * NH * 8) {
            H1_LOAD(unit0);
            for (int k = 0; k < 8; ++k) { const int unit = unit0 + k;
                float lf[16]; u32x4 vv[2];
#pragma unroll
                for (int it = 0; it < 2; ++it) { const int idx = tid + 512 * it; *(LAS u32x4*)(RawLF + (idx >> 4) * 128 + (idx & 15) * 8) = lfr[it]; }
                vv[0] = vvn[0]; vv[1] = vvn[1];
#pragma unroll
                for (int it = 0; it < 2; ++it) { const int idx = tid + 512 * it, s = idx >> 4, e8 = idx & 15;
#pragma unroll
                    for (int j = 0; j < 4; ++j) { const unsigned w = vv[it][j]; Vt[(e8 * 8 + 2 * j) * 72 + (s ^ ((e8 & 7) << 3))] = (bf16_t)(w & 0xffffu); Vt[(e8 * 8 + 2 * j + 1) * 72 + (s ^ ((e8 & 7) << 3))] = (bf16_t)(w >> 16); } }
                if (k + 1 < 8) H1_LOAD(unit + 1);
                __syncthreads();
                float lf0[8], lf1[8], bc0[8], bc1[8]; float run0 = 0.f, run1 = 0.f;
#pragma unroll
                for (int i = 0; i < 8; ++i) { const f32x2_t v2 = __builtin_convertvector(__builtin_bit_cast(h2v, *(const LAS unsigned*)(RawLF + (8 * part + i) * 128 + 2 * dp)), f32x2_t);
                    lf0[i] = v2.x; lf1[i] = v2.y; run0 += v2.x; run1 += v2.y; bc0[i] = run0; bc1[i] = run1; }
                *(LAS f32x2_t*)(PT + part * 128 + 2 * dp) = (f32x2_t){run0, run1};
                __syncthreads();
                float off0 = 0.f, off1 = 0.f;
#pragma unroll
                for (int p = 0; p < 7; ++p) if (p < part) { const f32x2_t pv = *(const LAS f32x2_t*)(PT + p * 128 + 2 * dp); off0 += pv.x; off1 += pv.y; }
                unsigned k0w[4], k1w[4];
#pragma unroll
                for (int i = 0; i < 8; i += 2) { const float ba = bc0[i] + off0, bb_ = bc0[i + 1] + off0, bc_ = bc1[i] + off1, bd = bc1[i + 1] + off1;
                    k0w[i >> 1] = cvt_pk_bf16((1.0f - __expf(lf0[i])) * __expf(-ba), (1.0f - __expf(lf0[i + 1])) * __expf(-bb_));
                    k1w[i >> 1] = cvt_pk_bf16((1.0f - __expf(lf1[i])) * __expf(-bc_), (1.0f - __expf(lf1[i + 1])) * __expf(-bd)); }
                *(LAS u32x4*)(Kt + (2 * dp) * 72 + 8 * part) = (u32x4){k0w[0], k0w[1], k0w[2], k0w[3]};
                *(LAS u32x4*)(Kt + (2 * dp + 1) * 72 + 8 * part) = (u32x4){k1w[0], k1w[1], k1w[2], k1w[3]};
                if (part == 7) { const float dc0 = __expf(bc0[7] + off0), dc1 = __expf(bc1[7] + off1); *(LAS f32x2_t*)(DEC + 2 * dp) = (f32x2_t){dc0, dc1}; dpre0 *= dc0; dpre1 *= dc1; }
                __syncthreads();
                bf16x8 a[2];
#pragma unroll
                for (int kk = 0; kk < 2; ++kk) a[kk] = *(const LAS bf16x8*)(Kt + (d0 + l15) * 72 + 8 * lq + 32 * kk);
                const f32x4 dv = *(const LAS f32x4*)(DEC + d0 + 4 * lq);
#pragma unroll
                for (int et = 0; et < 8; ++et) { f32x4 acc = {0.f, 0.f, 0.f, 0.f};
#pragma unroll
                    for (int kk = 0; kk < 2; ++kk) { const bf16x8 bf = *(const LAS bf16x8*)(Vt + (16 * et + l15) * 72 + 8 * ((lq + 4 * kk) ^ ((2 * et + (l15 >> 3)) & 7))); acc = __builtin_amdgcn_mfma_f32_16x16x32_bf16(a[kk], bf, acc, 0, 0, 0); }
                    Srun[et] = dv * (Srun[et] + acc); }
                __syncthreads();
            }
#pragma unroll
            for (int et = 0; et < 8; ++et) { u32x2 w2; w2.x = cvt_pk_bf16(Srun[et][0], Srun[et][1]); w2.y = cvt_pk_bf16(Srun[et][2], Srun[et][3]);
                *(u32x2*)(Aseg + (size_t)segid * (HD * HD) + (16 * et + l15) * HD + d0 + 4 * lq) = w2; }
            if (part == 7) *(f32x2_t*)(Dseg + segid * HD + 2 * dp) = (f32x2_t){dpre0, dpre1};
            }
        }
    }
    SEAM(2);

    if (IN(3)) {
        for (int idx = blockIdx.x * NTHR + tid; idx < BATCH * NH * HD * (HD / 4); idx += G * NTHR) {
            const int bh = idx >> 12, el = idx & 4095, d4 = el & 31;
            float E0 = 0.f, E1 = 0.f, E2 = 0.f, E3 = 0.f;
#pragma unroll
            for (int j = 0; j < 8; ++j) { const size_t o = (size_t)(bh * 8 + j) * (HD * HD) + (size_t)el * 4;
                const u32x2 av = *(const u32x2*)(Aseg + o); const f32x4 dv = *(const f32x4*)(Dseg + (bh * 8 + j) * HD + d4 * 4);
                u32x2 sv; sv.x = cvt_pk_bf16(E0, E1); sv.y = cvt_pk_bf16(E2, E3); *(u32x2*)(Eseg + o) = sv;
                E0 = bflo(av.x) + dv[0] * E0; E1 = bfhi(av.x) + dv[1] * E1; E2 = bflo(av.y) + dv[2] * E2; E3 = bfhi(av.y) + dv[3] * E3; }
        }
    }
    SEAM(3);

    if (IN(4)) {
        LAS bf16_t* Qs = (LAS bf16_t*)(lds);
        LAS bf16_t* Ks = (LAS bf16_t*)(lds + 17408);
        LAS bf16_t* Vt = (LAS bf16_t*)(lds + 34816);
        LAS bf16_t* St = (LAS bf16_t*)(lds + 53248);
        LAS bf16_t* As = (LAS bf16_t*)(lds + 88064);
        LAS float* PT = (LAS float*)(lds + 135168);
        LAS float* SS = (LAS float*)(lds + 99328);
        LAS _Float16* RawLF = (LAS _Float16*)(lds);
        LAS bf16_t* RawQ = (LAS bf16_t*)(lds + 99840);
        LAS bf16_t* Kt = (LAS bf16_t*)(lds + 116224);
        LAS float* DEC = (LAS float*)(lds + 134656);
        const float* recg = args.in[9];
        const int dp = tid & 63, part = tid >> 6, l15 = lane & 15, lq = lane >> 4;
        typedef _Float16 h2v __attribute__((ext_vector_type(2)));
        u32x4 lfr[2], qr[2], vvn[2]; u32x2 gvn[4]; f32x4 rgn[4];
        const int o_tt = wave & 3, o_eh = wave >> 2;
#define H3_LOAD(unit_) do { const int c_ = (unit_) & 63, bh_ = (unit_) >> 6, h_ = bh_ & 3, b_ = bh_ >> 2; const size_t r0_ = (size_t)b_ * SEQ + 64 * c_; \
            _Pragma("unroll") for (int it = 0; it < 2; ++it) { const int idx = tid + 512 * it; lfr[it] = __builtin_nontemporal_load((const u32x4*)(logf + (r0_ + (idx >> 4)) * DR + h_ * HD + (idx & 15) * 8)); } \
            _Pragma("unroll") for (int it = 0; it < 2; ++it) { const int idx = tid + 512 * it; qr[it] = __builtin_nontemporal_load((const u32x4*)(qb + (r0_ + (idx >> 4)) * DR + h_ * HD + (idx & 15) * 8)); } \
            _Pragma("unroll") for (int it = 0; it < 2; ++it) { const int idx = tid + 512 * it, s = idx >> 4, e8 = idx & 15; vvn[it] = __builtin_nontemporal_load((const u32x4*)(vb + (r0_ + s) * DR + h_ * HD + e8 * 8)); } \
            _Pragma("unroll") for (int et = 0; et < 4; ++et) { const int e_ = 16 * (4 * o_eh + et) + 4 * lq; gvn[et] = __builtin_nontemporal_load((const u32x2*)(gs + (r0_ + 16 * o_tt + l15) * DR + h_ * HD + e_)); } } while (0)
        const int segid = (int)blockIdx.x, unit0 = ((segid >> 3) << 6) | ((segid & 7) << 3);
        if (segid < BATCH * NH * 8) {
        const int d0 = 16 * wave;
        f32x4 Srun[8];
#pragma unroll
        for (int et = 0; et < 8; ++et) { const u32x2 ev = *(const u32x2*)(Eseg + (size_t)segid * (HD * HD) + (16 * et + l15) * HD + d0 + 4 * lq); Srun[et] = (f32x4){bflo(ev.x), bfhi(ev.x), bflo(ev.y), bfhi(ev.y)}; }
#pragma unroll
        for (int et = 0; et < 4; ++et) rgn[et] = *(const f32x4*)(recg + ((segid >> 3) & 3) * HD + 16 * (4 * o_eh + et) + 4 * lq);
        H3_LOAD(unit0);
        for (int k8 = 0; k8 < 8; ++k8) { const int unit = unit0 + k8;
            const int c = unit & 63, bh = unit >> 6, h = bh & 3, b = bh >> 2; const size_t r0 = (size_t)b * SEQ + 64 * c;
            float lf[16]; float qv[16]; u32x4 vv[2];
#pragma unroll
            for (int it = 0; it < 2; ++it) { const int idx = tid + 512 * it; *(LAS u32x4*)(RawLF + (idx >> 4) * 128 + (idx & 15) * 8) = lfr[it]; }
#pragma unroll
            for (int it = 0; it < 2; ++it) { const int idx = tid + 512 * it; *(LAS u32x4*)(RawQ + (idx >> 4) * 128 + (idx & 15) * 8) = qr[it]; }
            vv[0] = vvn[0]; vv[1] = vvn[1];
#pragma unroll
            for (int et = 0; et < 8; ++et) { u32x2 w2; w2.x = cvt_pk_bf16(Srun[et][0], Srun[et][1]); w2.y = cvt_pk_bf16(Srun[et][2], Srun[et][3]); *(LAS u32x2*)(St + (16 * et + l15) * 136 + d0 + 4 * lq) = w2; }
            u32x2 gv[4]; f32x4 rgv[4];
#pragma unroll
            for (int et = 0; et < 4; ++et) { gv[et] = gvn[et]; rgv[et] = rgn[et]; }
#pragma unroll
            for (int it = 0; it < 2; ++it) { const int idx = tid + 512 * it, s = idx >> 4, e8 = idx & 15;
#pragma unroll
                for (int j = 0; j < 4; ++j) { const unsigned w = vv[it][j]; Vt[(e8 * 8 + 2 * j) * 72 + (s ^ ((e8 & 7) << 3))] = (bf16_t)(w & 0xffffu); Vt[(e8 * 8 + 2 * j + 1) * 72 + (s ^ ((e8 & 7) << 3))] = (bf16_t)(w >> 16); } }
            if (k8 + 1 < 8) H3_LOAD(unit + 1);
            __syncthreads();
            float lf0[8], lf1[8], q0[8], q1[8], bc0[8], bc1[8]; float run0 = 0.f, run1 = 0.f;
#pragma unroll
            for (int i = 0; i < 8; ++i) { const f32x2_t v2 = __builtin_convertvector(__builtin_bit_cast(h2v, *(const LAS unsigned*)(RawLF + (8 * part + i) * 128 + 2 * dp)), f32x2_t);
                const unsigned qw = *(const LAS unsigned*)(RawQ + (8 * part + i) * 128 + 2 * dp); q0[i] = bflo(qw); q1[i] = bfhi(qw);
                lf0[i] = v2.x; lf1[i] = v2.y; run0 += v2.x; run1 += v2.y; bc0[i] = run0; bc1[i] = run1; }
            *(LAS f32x2_t*)(PT + part * 128 + 2 * dp) = (f32x2_t){run0, run1};
            __syncthreads();
            float off0 = 0.f, off1 = 0.f;
#pragma unroll
            for (int p = 0; p < 7; ++p) if (p < part) { const f32x2_t pv = *(const LAS f32x2_t*)(PT + p * 128 + 2 * dp); off0 += pv.x; off1 += pv.y; }
            unsigned k0w[4], k1w[4];
#pragma unroll
            for (int i = 0; i < 8; i += 2) {
                float kk0[2], kk1[2];
#pragma unroll
                for (int u2 = 0; u2 < 2; ++u2) { const float ba = bc0[i + u2] + off0, bb_ = bc1[i + u2] + off1;
                    const float qa = q0[i + u2] * __expf(ba), qb_ = q1[i + u2] * __expf(bb_);
                    kk0[u2] = (1.0f - __expf(lf0[i + u2])) * __expf(-ba); kk1[u2] = (1.0f - __expf(lf1[i + u2])) * __expf(-bb_);
                    *(LAS unsigned*)(Qs + (8 * part + i + u2) * 136 + 2 * dp) = cvt_pk_bf16(qa, qb_);
                    *(LAS unsigned*)(Ks + (8 * part + i + u2) * 136 + 2 * dp) = cvt_pk_bf16(kk0[u2], kk1[u2]); }
                k0w[i >> 1] = cvt_pk_bf16(kk0[0], kk0[1]); k1w[i >> 1] = cvt_pk_bf16(kk1[0], kk1[1]); }
            *(LAS u32x4*)(Kt + (2 * dp) * 72 + 8 * part) = (u32x4){k0w[0], k0w[1], k0w[2], k0w[3]};
            *(LAS u32x4*)(Kt + (2 * dp + 1) * 72 + 8 * part) = (u32x4){k1w[0], k1w[1], k1w[2], k1w[3]};
            if (part == 7) *(LAS f32x2_t*)(DEC + 2 * dp) = (f32x2_t){__expf(bc0[7] + off0), __expf(bc1[7] + off1)};
            __syncthreads();
            {
                bf16x8 ka[2];
#pragma unroll
                for (int kk = 0; kk < 2; ++kk) ka[kk] = *(const LAS bf16x8*)(Kt + (d0 + l15) * 72 + 8 * lq + 32 * kk);
                const f32x4 dv = *(const LAS f32x4*)(DEC + d0 + 4 * lq);
#pragma unroll
                for (int et = 0; et < 8; ++et) { f32x4 acc = {0.f, 0.f, 0.f, 0.f};
#pragma unroll
                    for (int kk = 0; kk < 2; ++kk) { const bf16x8 bf = *(const LAS bf16x8*)(Vt + (16 * et + l15) * 72 + 8 * ((lq + 4 * kk) ^ ((2 * et + (l15 >> 3)) & 7))); acc = __builtin_amdgcn_mfma_f32_16x16x32_bf16(ka[kk], bf, acc, 0, 0, 0); }
                    Srun[et] = dv * (Srun[et] + acc); }
            }
            {
                const int tt = wave >> 1;
#pragma unroll
                for (int sti = 0; sti < 2; ++sti) { const int st = 2 * (wave & 1) + sti; f32x4 acc = {0.f, 0.f, 0.f, 0.f};
                    if (st <= tt) {
#pragma unroll
                        for (int kk = 0; kk < 4; ++kk) { const bf16x8 ak = *(const LAS bf16x8*)(Ks + (16 * st + l15) * 136 + 8 * lq + 32 * kk); const bf16x8 bq = *(const LAS bf16x8*)(Qs + (16 * tt + l15) * 136 + 8 * lq + 32 * kk);
                            acc = __builtin_amdgcn_mfma_f32_16x16x32_bf16(ak, bq, acc, 0, 0, 0); } }
                    const int t = 16 * tt + l15, s0 = 16 * st + 4 * lq;
#pragma unroll
                    for (int r = 0; r < 4; ++r) if (s0 + r > t) acc[r] = 0.f;
                    u32x2 w2; w2.x = cvt_pk_bf16(acc[0], acc[1]); w2.y = cvt_pk_bf16(acc[2], acc[3]);
                    *(LAS u32x2*)(As + t * 72 + s0) = w2; }
            }
            __syncthreads();
            {
                const int tt = wave & 3, eh = wave >> 2, t = 16 * tt + l15;
                bf16x8 bA[2], bQ[4];
#pragma unroll
                for (int kk = 0; kk < 2; ++kk) bA[kk] = *(const LAS bf16x8*)(As + t * 72 + 8 * lq + 32 * kk);
#pragma unroll
                for (int kk = 0; kk < 4; ++kk) bQ[kk] = *(const LAS bf16x8*)(Qs + t * 136 + 8 * lq + 32 * kk);
                f32x4 o[4]; float ss = 0.f;
#pragma unroll
                for (int et = 0; et < 4; ++et) { const int e0 = 16 * (4 * eh + et);
                    f32x4 acc = {0.f, 0.f, 0.f, 0.f};
#pragma unroll
                    for (int kk = 0; kk < 2; ++kk) { const bf16x8 av = *(const LAS bf16x8*)(Vt + (e0 + l15) * 72 + 8 * ((lq + 4 * kk) ^ (((e0 >> 3) + (l15 >> 3)) & 7))); acc = __builtin_amdgcn_mfma_f32_16x16x32_bf16(av, bA[kk], acc, 0, 0, 0); }
#pragma unroll
                    for (int kk = 0; kk < 4; ++kk) { const bf16x8 as = *(const LAS bf16x8*)(St + (e0 + l15) * 136 + 8 * lq + 32 * kk); acc = __builtin_amdgcn_mfma_f32_16x16x32_bf16(as, bQ[kk], acc, 0, 0, 0); }
                    o[et] = acc; ss += (acc[0] * acc[0] + acc[1] * acc[1]) + (acc[2] * acc[2] + acc[3] * acc[3]); }
                ss += __shfl_xor(ss, 16); ss += __shfl_xor(ss, 32);
                if (lq == 0) SS[t * 2 + eh] = ss;
                __syncthreads();
                const float rs = __builtin_amdgcn_rsqf((SS[t * 2] + SS[t * 2 + 1]) * (1.0f / HD) + EPS);
#pragma unroll
                for (int et = 0; et < 4; ++et) { const int e = 16 * (4 * eh + et) + 4 * lq; const f32x4 rg = rgv[et];
                    const float y0 = o[et][0] * rs * rg[0] * bflo(gv[et].x), y1 = o[et][1] * rs * rg[1] * bfhi(gv[et].x), y2 = o[et][2] * rs * rg[2] * bflo(gv[et].y), y3 = o[et][3] * rs * rg[3] * bfhi(gv[et].y);
                    u32x2 w2; w2.x = cvt_pk_bf16(y0, y1); w2.y = cvt_pk_bf16(y2, y3);
                    *(u32x2*)(yb + (r0 + t) * D + DC + h * HD + e) = w2; }
            }
            __syncthreads();
        }
        }
    }
    SEAM(4);

    if (IN(5)) { pg8::Gemm g{yb, WoutT, M, D, D}; pg8::StaticOrder S; S.init(M, D, G, (int)blockIdx.x);
        pg8::EpiOut E{xb, ssq2, rstd1};
        pg8::gemm_phase<pg8::EpiOut, pg8::StaticOrder, true, true>(lds, g, S, E);
        { pg8::Gemm g{pb, WpleT, M, D, PLE}; pg8::StaticOrder S; S.init(M, D, G, (int)blockIdx.x);
          pg8::EpiPle E{eb, ssqE};
          pg8::gemm_phase<pg8::EpiPle, pg8::StaticOrder, true, true>(lds, g, S, E); }
    }
    SEAM(5);
    if (IN(6)) { pg8::Gemm g{xb, WupT, M, FF, D}; pg8::StaticOrder S; S.init(M, FF, G, (int)blockIdx.x);
        pg8::EpiUp E{tb};
        pg8::gemm_phase<pg8::EpiUp, pg8::StaticOrder, true, true>(lds, g, S, E); }
    SEAM(6);
    if (IN(7)) { pg8::Gemm g{tb, WdownT, M, D, FF}; pg8::StaticOrder S; S.init(M, D, G, (int)blockIdx.x);
        pg8::EpiDown E{ssq2, xb};
        pg8::gemm_phase<pg8::EpiDown, pg8::StaticOrder, true, true>(lds, g, S, E); }
    SEAM(7);
    if (IN(8)) { pg8::Gemm g{xb, WgateT, M, D, D}; pg8::StaticOrder S; S.init(M, D, G, (int)blockIdx.x);
        pg8::EpiGateFinal E{outp, xb, eb, ssqE, args.in[15], ssq3, (unsigned*)(ws + WS_PCNT), args.in[17]};
        pg8::gemm_phase<pg8::EpiGateFinal, pg8::StaticOrder, true, true>(lds, g, S, E); }
    if (DBG_TS >= 0) { xcd_barrier(bar); if (blockIdx.x == 0 && tid == 0) { if (DBG_TS == 8) tsw[1] = __builtin_amdgcn_s_memrealtime() - tsw[0]; outp[0] = 4.0f * rintf((float)tsw[1] * 0.01f * 0.25f); } }
#undef IN
#undef SEAM
}

#ifndef DBG_STOP
#define DBG_STOP -1
#endif
#ifndef DBG_OFF
#define DBG_OFF (WS_LOGF + 32 * MiB)
#endif
__global__ void dbg_dump(const unsigned short* src, float* o, int n) { for (int i = blockIdx.x * blockDim.x + threadIdx.x; i < n; i += gridDim.x * blockDim.x) o[i] = (float)src[i]; }
extern "C" void kernel_launch(void* const* d_in, const int* in_sizes, int n_in, void* d_out, int out_size, void* d_ws, size_t ws_size, hipStream_t stream) {
    static int grid = 0;
    if (grid == 0) {
        if (n_in != 18 || in_sizes[0] != M * D || out_size != M * D || ws_size < WS_END) { fprintf(stderr, "kernel_launch: unexpected shapes (n_in %d, in0 %d, out %d, ws %zu)\n", n_in, n_in > 0 ? in_sizes[0] : -1, out_size, ws_size); grid = -1; return; }
        int dev = 0, cus = 0, per_cu = 0;
        hipGetDevice(&dev); hipDeviceGetAttribute(&cus, hipDeviceAttributeMultiprocessorCount, dev);
        if (hipFuncSetAttribute((const void*)mk_fwd, hipFuncAttributeMaxDynamicSharedMemorySize, LDS_BYTES) != hipSuccess) { fprintf(stderr, "kernel_launch: hipFuncSetAttribute failed\n"); grid = -1; return; }
        if (hipOccupancyMaxActiveBlocksPerMultiprocessor(&per_cu, (const void*)mk_fwd, NTHR, LDS_BYTES) != hipSuccess || per_cu < 1) { fprintf(stderr, "kernel_launch: occupancy query says %d\n", per_cu); per_cu = 1; }
        (void)hipGetLastError();
        grid = cus;
    }
    if (grid < 0) return;
    Args a{};
    for (int i = 0; i < 18; ++i) a.in[i] = (const float*)d_in[i];
    a.out = (float*)d_out; a.ws = (unsigned char*)d_ws;
#if MK_COOP
    if (hipMemsetAsync((char*)d_ws + WS_BAR, 0, 96 * 1024, stream) != hipSuccess) { fprintf(stderr, "kernel_launch: memset of the barrier words failed\n"); return; }
    a.ph_lo = 0; a.ph_hi = N_PHASES;
    void* kargs[] = {&a};
    hipError_t e = hipLaunchCooperativeKernel((const void*)mk_fwd, dim3(grid), dim3(NTHR), kargs, LDS_BYTES, stream);
    if (e != hipSuccess) fprintf(stderr, "cooperative launch failed: %s (grid %d)\n", hipGetErrorString(e), grid);
#else
    for (int p = 0; p < N_PHASES; ++p) { if (DBG_STOP >= 0 && p > DBG_STOP) break; a.ph_lo = p; a.ph_hi = p + 1; hipLaunchKernelGGL(mk_fwd, dim3(grid), dim3(NTHR), LDS_BYTES, stream, a); }
    if (DBG_STOP >= 0) hipLaunchKernelGGL(dbg_dump, dim3(2048), dim3(256), 0, stream, (const unsigned short*)((unsigned char*)d_ws + DBG_OFF), (float*)d_out, M * D);
#endif
}
```

```cpp
#include <hip/hip_runtime.h>
#include <hip/hip_cooperative_groups.h>
#include <cstdio>
#include <cstdint>
namespace cg = cooperative_groups;
namespace pg8 {
#define PG8_LAS __attribute__((address_space(3)))
typedef unsigned short bf16_t;
typedef short bf16x8 __attribute__((ext_vector_type(8)));
typedef float f32x4 __attribute__((ext_vector_type(4)));
typedef unsigned u32x4 __attribute__((ext_vector_type(4)));
constexpr int BM = 256, BK = 64, HALF = 128, HTB = HALF * BK * 2  , STAGE_BYTES = 8 * HTB, NXCD = 8, WGM = 8;

__host__ __device__ __forceinline__ int lds_byte(int r, int c) { const int st = (r >> 4) * 2 + (c >> 5), rr = r & 15, cc = c & 31, ob = rr * 64 + cc * 2; return st * 1024 + (ob ^ (((ob >> 9) & 1) << 5)); }
__host__ __device__ __forceinline__ void stage_rc(int b, int& R, int& C) { const int st = b / 1024, sb = b % 1024, swz = sb ^ (((sb >> 9) & 1) << 5); R = (st >> 1) * 16 + swz / 64; C = (st & 1) * 32 + (swz % 64) / 2; }
__host__ __device__ __forceinline__ int perm32(int rho) { const int n = rho >> 4, i = rho & 15; return 8 * (i >> 2) + 4 * n + (i & 3); }

struct Unit { int pm, pn; };
struct Gemm { const bf16_t* A; const bf16_t* Bt; int M, N, K; };

struct StaticOrder {
    int nM, nN, nwg, G, c;
    __host__ __device__ void init(int M, int N, int G_, int c_) { nM = M / BM; nN = N / BM; nwg = nM * nN; G = G_; c = c_; }
    __host__ __device__ bool next(int i, Unit& u) const {
        const long L = (long)i * G + c; if (L >= nwg) return false;
        int wgid = (int)L; { const int q = nwg / NXCD, r = nwg % NXCD, xcd = wgid % NXCD, off = wgid / NXCD; wgid = (xcd < r ? xcd * (q + 1) : r * (q + 1) + (xcd - r) * q) + off; }
        const int nig = WGM * nN, gid = wgid / nig, fm = gid * WGM, gsz = (nM - fm) < WGM ? (nM - fm) : WGM;
        u.pm = fm + ((wgid % nig) % gsz); u.pn = (wgid % nig) / gsz; return true;
    }
    __device__ __forceinline__ void a_ready(const Unit&) const {}
    __device__ __forceinline__ void done(const Unit&) const {}
};

typedef __bf16 bf16x2_t __attribute__((ext_vector_type(2)));
typedef float f32x2_t __attribute__((ext_vector_type(2)));
__device__ __forceinline__ unsigned cvt_pk_bf16(float lo, float hi) { const f32x2_t v = {lo, hi}; const bf16x2_t b = __builtin_convertvector(v, bf16x2_t); return __builtin_bit_cast(unsigned, b); }
typedef float f32x2 __attribute__((ext_vector_type(2)));
typedef unsigned u32x2 __attribute__((ext_vector_type(2)));
__device__ __forceinline__ float sigm(float x) { return __builtin_amdgcn_rcpf(1.0f + __expf(-x)); }
__device__ __forceinline__ unsigned cvt_pk_bf16_asm(float lo, float hi) { unsigned r; asm volatile("v_cvt_pk_bf16_f32 %0, %1, %2" : "=v"(r) : "v"(lo), "v"(hi)); return r; }
__device__ __forceinline__ u32x4 pack8(const f32x4& a, const f32x4& b) { u32x4 w; w.x = cvt_pk_bf16_asm(a[0], a[1]); w.y = cvt_pk_bf16_asm(a[2], a[3]); w.z = cvt_pk_bf16_asm(b[0], b[1]); w.w = cvt_pk_bf16_asm(b[2], b[3]); return w; }
__device__ __forceinline__ u32x4 pack8v(const f32x4& a, const f32x4& b) { u32x4 w; w.x = cvt_pk_bf16(a[0], a[1]); w.y = cvt_pk_bf16(a[2], a[3]); w.z = cvt_pk_bf16(b[0], b[1]); w.w = cvt_pk_bf16(b[2], b[3]); return w; }
__device__ __forceinline__ float bflo(unsigned w) { return __uint_as_float(w << 16); }
__device__ __forceinline__ float bfhi(unsigned w) { return __uint_as_float(w & 0xffff0000u); }
constexpr float EPS_ = 1e-6f;

struct EpiIn {
    static constexpr bool PERM = true, AFTER_DRAIN = false;
    const float* rstd1; const float* lbl; bf16_t* cglu; bf16_t* qb; bf16_t* gs; _Float16* logf; bf16_t* vb;
    __device__ __forceinline__ void operator()(const f32x4 (&acc)[2][2][4][2], const Unit& u, int wr, int wc, int fr, int fq) const {
        asm volatile("s_nop 15\n\ts_nop 15" ::: "memory");
        const int kind = u.pn >> 2, j = u.pn & 3;
        const int col = j * 128 + wc * 32 + 8 * fq;
        const int row0 = u.pm * BM + wr * 64 + fr;
        if (kind == 0) {
#pragma unroll
            for (int ai = 0; ai < 2; ++ai)
#pragma unroll
                for (int m = 0; m < 4; ++m) { const int row = row0 + ai * HALF + m * 16;
                    f32x4 a0 = acc[ai][0][m][0], a1 = acc[ai][0][m][1], b0 = acc[ai][1][m][0], b1 = acc[ai][1][m][1];
#pragma unroll
                    for (int e = 0; e < 4; ++e) { a0[e] *= sigm(b0[e]); a1[e] *= sigm(b1[e]); }
                    *(u32x4*)(cglu + (size_t)row * 512 + col) = pack8(a0, a1); }
        } else if (kind == 1) {
#pragma unroll
            for (int ai = 0; ai < 2; ++ai)
#pragma unroll
                for (int m = 0; m < 4; ++m) { const int row = row0 + ai * HALF + m * 16;
                    f32x4 a0 = acc[ai][0][m][0], a1 = acc[ai][0][m][1], b0 = acc[ai][1][m][0], b1 = acc[ai][1][m][1];
#pragma unroll
                    for (int e = 0; e < 4; ++e) { b0[e] *= sigm(b0[e]); b1[e] *= sigm(b1[e]); }
                    __builtin_nontemporal_store(pack8(a0, a1), (u32x4*)(qb + (size_t)row * 512 + col));
                    __builtin_nontemporal_store(pack8(b0, b1), (u32x4*)(gs + (size_t)row * 512 + col)); }
        } else {
            float lb[8];
#pragma unroll
            for (int e = 0; e < 8; ++e) lb[e] = __builtin_amdgcn_rcpf(1.0f + __expf(lbl[512 + col + e] - lbl[col + e]));
#pragma unroll
            for (int ai = 0; ai < 2; ++ai)
#pragma unroll
                for (int m = 0; m < 4; ++m) { const int row = row0 + ai * HALF + m * 16;
                    f32x4 a0 = acc[ai][0][m][0], a1 = acc[ai][0][m][1], b0 = acc[ai][1][m][0], b1 = acc[ai][1][m][1];
#pragma unroll
                    for (int e = 0; e < 4; ++e) { a0[e] = 0.69314718056f * __builtin_amdgcn_logf(lb[e] + (1.0f - lb[e]) * sigm(a0[e])); a1[e] = 0.69314718056f * __builtin_amdgcn_logf(lb[4 + e] + (1.0f - lb[4 + e]) * sigm(a1[e])); }
                    { typedef _Float16 h2_t __attribute__((ext_vector_type(2))); u32x4 w;
                      w.x = __builtin_bit_cast(unsigned, __builtin_convertvector((f32x2_t){a0[0], a0[1]}, h2_t)); w.y = __builtin_bit_cast(unsigned, __builtin_convertvector((f32x2_t){a0[2], a0[3]}, h2_t));
                      w.z = __builtin_bit_cast(unsigned, __builtin_convertvector((f32x2_t){a1[0], a1[1]}, h2_t)); w.w = __builtin_bit_cast(unsigned, __builtin_convertvector((f32x2_t){a1[2], a1[3]}, h2_t));
                      *(u32x4*)(logf + (size_t)row * 512 + col) = w; }
                    *(u32x4*)(vb + (size_t)row * 512 + col) = pack8(b0, b1); }
        }
    }
};
struct EpiPle {
    static constexpr bool PERM = true, AFTER_DRAIN = false;
    bf16_t* e; float* ssq;
    __device__ __forceinline__ void operator()(const f32x4 (&acc)[2][2][4][2], const Unit& u, int wr, int wc, int fr, int fq) const {
        asm volatile("s_nop 15\n\ts_nop 15" ::: "memory");
        const int row0 = u.pm * BM + wr * 64 + fr, col0 = u.pn * BM + wc * 32 + 8 * fq;
#pragma unroll
        for (int ai = 0; ai < 2; ++ai)
#pragma unroll
            for (int m = 0; m < 4; ++m) { const int row = row0 + ai * HALF + m * 16; float ss = 0.f;
#pragma unroll
                for (int bj = 0; bj < 2; ++bj) { const f32x4 a0 = acc[ai][bj][m][0], a1 = acc[ai][bj][m][1];
                    __builtin_nontemporal_store(pack8(a0, a1), (u32x4*)(e + (size_t)row * 1024 + col0 + bj * HALF));
                    ss += (a0[0] * a0[0] + a0[1] * a0[1]) + (a0[2] * a0[2] + a0[3] * a0[3]) + (a1[0] * a1[0] + a1[1] * a1[1]) + (a1[2] * a1[2] + a1[3] * a1[3]); }
                ss += __shfl_xor(ss, 16); ss += __shfl_xor(ss, 32);
                if (fq == 0) __hip_atomic_fetch_add(ssq + row, ss, __ATOMIC_RELAXED, __HIP_MEMORY_SCOPE_AGENT); }
    }
};
struct EpiOut {
    static constexpr bool PERM = true, AFTER_DRAIN = false;
    bf16_t* hb; float* ssq; const float* inv1;
    __device__ __forceinline__ void operator()(const f32x4 (&acc)[2][2][4][2], const Unit& u, int wr, int wc, int fr, int fq) const {
        asm volatile("s_nop 15\n\ts_nop 15" ::: "memory");
        const int row0 = u.pm * BM + wr * 64 + fr, col0 = u.pn * BM + wc * 32 + 8 * fq;
        float iv[8];
#pragma unroll
        for (int g = 0; g < 8; ++g) iv[g] = inv1[row0 + (g >> 2) * HALF + (g & 3) * 16];
        u32x4 hq[8][2];
#define EPI_H(g_) do { _Pragma("unroll") for (int bj = 0; bj < 2; ++bj) hq[g_][bj] = *(const u32x4*)(hb + (size_t)(row0 + ((g_) >> 2) * HALF + ((g_) & 3) * 16) * 1024 + col0 + bj * HALF); } while (0)
        EPI_H(0); EPI_H(1); EPI_H(2); EPI_H(3);
        asm volatile("" ::: "memory");
#pragma unroll
        for (int g = 0; g < 8; ++g) { const int ai = g >> 2, m = g & 3; const int row = row0 + ai * HALF + m * 16; float ss = 0.f;
            if (g + 4 < 8) EPI_H(g + 4);
#pragma unroll
            for (int bj = 0; bj < 2; ++bj) { const size_t off = (size_t)row * 1024 + col0 + bj * HALF;
                const u32x4 hv = hq[g][bj];
                const f32x4 h0 = {bflo(hv.x), bfhi(hv.x), bflo(hv.y), bfhi(hv.y)}, h1 = {bflo(hv.z), bfhi(hv.z), bflo(hv.w), bfhi(hv.w)};
                const f32x4 a0 = h0 * iv[g] + acc[ai][bj][m][0], a1 = h1 * iv[g] + acc[ai][bj][m][1];
                *(u32x4*)(hb + off) = pack8(a0, a1);
                ss += (a0[0] * a0[0] + a0[1] * a0[1]) + (a0[2] * a0[2] + a0[3] * a0[3]) + (a1[0] * a1[0] + a1[1] * a1[1]) + (a1[2] * a1[2] + a1[3] * a1[3]); }
            ss += __shfl_xor(ss, 16); ss += __shfl_xor(ss, 32);
            if (fq == 0) __hip_atomic_fetch_add(ssq + row, ss, __ATOMIC_RELAXED, __HIP_MEMORY_SCOPE_AGENT);
            asm volatile("" ::: "memory"); }
#undef EPI_H
    }
};
struct EpiUp {
    static constexpr bool PERM = true, AFTER_DRAIN = false;
    bf16_t* t;
    __device__ __forceinline__ void operator()(const f32x4 (&acc)[2][2][4][2], const Unit& u, int wr, int wc, int fr, int fq) const {
        asm volatile("s_nop 15\n\ts_nop 15" ::: "memory");
        const int row0 = u.pm * BM + wr * 64 + fr, col0 = u.pn * BM + wc * 32 + 8 * fq;
#pragma unroll
        for (int ai = 0; ai < 2; ++ai)
#pragma unroll
            for (int m = 0; m < 4; ++m) { const int row = row0 + ai * HALF + m * 16;
#pragma unroll
                for (int bj = 0; bj < 2; ++bj) { f32x4 a0 = acc[ai][bj][m][0], a1 = acc[ai][bj][m][1];
#pragma unroll
                    for (int e = 0; e < 4; ++e) { const float p = fmaxf(a0[e], 0.f), q = fmaxf(a1[e], 0.f); a0[e] = p * p; a1[e] = q * q; }
                    *(u32x4*)(t + (size_t)row * 4096 + col0 + bj * HALF) = pack8(a0, a1); } }
    }
};
struct EpiDown {
    static constexpr bool PERM = true, AFTER_DRAIN = false;
    const float* ssq2; bf16_t* hb;
    __device__ __forceinline__ void operator()(const f32x4 (&acc)[2][2][4][2], const Unit& u, int wr, int wc, int fr, int fq) const {
        asm volatile("s_nop 15\n\ts_nop 15" ::: "memory");
        const int row0 = u.pm * BM + wr * 64 + fr, col0 = u.pn * BM + wc * 32 + 8 * fq;
        u32x4 hq[8][2]; float sq[8];
#pragma unroll
        for (int g = 0; g < 8; ++g) sq[g] = ssq2[row0 + (g >> 2) * HALF + (g & 3) * 16];
#define EPI_H(g_) do { _Pragma("unroll") for (int bj = 0; bj < 2; ++bj) hq[g_][bj] = *(const u32x4*)(hb + (size_t)(row0 + ((g_) >> 2) * HALF + ((g_) & 3) * 16) * 1024 + col0 + bj * HALF); } while (0)
        EPI_H(0); EPI_H(1); EPI_H(2); EPI_H(3);
        asm volatile("" ::: "memory");
#pragma unroll
        for (int g = 0; g < 8; ++g) { const int ai = g >> 2, m = g & 3; const int row = row0 + ai * HALF + m * 16; const float r2 = __builtin_amdgcn_rcpf(sq[g] * (1.0f / 1024.0f) + EPS_);
            if (g + 4 < 8) EPI_H(g + 4);
#pragma unroll
            for (int bj = 0; bj < 2; ++bj) { const size_t off = (size_t)row * 1024 + col0 + bj * HALF;
                const u32x4 hv = hq[g][bj];
                const f32x4 h0 = {bflo(hv.x), bfhi(hv.x), bflo(hv.y), bfhi(hv.y)}, h1 = {bflo(hv.z), bfhi(hv.z), bflo(hv.w), bfhi(hv.w)};
                const f32x4 a0 = h0 + acc[ai][bj][m][0] * r2, a1 = h1 + acc[ai][bj][m][1] * r2;
                *(u32x4*)(hb + off) = pack8(a0, a1); }
            asm volatile("" ::: "memory"); }
#undef EPI_H
    }
};
struct EpiGateFinal {
    static constexpr bool PERM = true, AFTER_DRAIN = false;
    float* out; const bf16_t* hb; const bf16_t* e; const float* ssqE; const float* gple; float* ssq3; unsigned* cnt; const float* gfin;
    __device__ __forceinline__ void operator()(f32x4 (&acc)[2][2][4][2], const Unit& u, int wr, int wc, int fr, int fq) const {
        asm volatile("s_nop 15\n\ts_nop 15" ::: "memory");
        const int row0 = u.pm * BM + wr * 64 + fr, col0 = u.pn * BM + wc * 32 + 8 * fq;
        {
        u32x4 hq[8][2], eq[8][2]; float sq[8];
#define EGF_E(g_) do { _Pragma("unroll") for (int bj = 0; bj < 2; ++bj) eq[g_][bj] = __builtin_nontemporal_load((const u32x4*)(e + (size_t)(row0 + ((g_) >> 2) * HALF + ((g_) & 3) * 16) * 1024 + col0 + bj * HALF)); } while (0)
#pragma unroll
        for (int g = 0; g < 8; ++g) sq[g] = ssqE[row0 + (g >> 2) * HALF + (g & 3) * 16];
#define EGF_H(g_) do { _Pragma("unroll") for (int bj = 0; bj < 2; ++bj) hq[g_][bj] = *(const u32x4*)(hb + (size_t)(row0 + ((g_) >> 2) * HALF + ((g_) & 3) * 16) * 1024 + col0 + bj * HALF); } while (0)
        EGF_H(0); EGF_E(0); EGF_H(1); EGF_E(1);
        f32x4 gp[2][2];
#pragma unroll
        for (int bj = 0; bj < 2; ++bj) { gp[bj][0] = *(const f32x4*)(gple + col0 + bj * HALF); gp[bj][1] = *(const f32x4*)(gple + col0 + bj * HALF + 4); }
        asm volatile("" ::: "memory");
#pragma unroll
        for (int g = 0; g < 8; ++g) { const int ai = g >> 2, m = g & 3; const int row = row0 + ai * HALF + m * 16; const float rE = __builtin_amdgcn_rsqf(sq[g] * (1.0f / 1024.0f) + EPS_); float ss = 0.f;
            if (g + 2 < 8) { EGF_H(g + 2); EGF_E(g + 2); }
#pragma unroll
            for (int bj = 0; bj < 2; ++bj) {
                const u32x4 ev = eq[g][bj];
                f32x4 e0 = {bflo(ev.x), bfhi(ev.x), bflo(ev.y), bfhi(ev.y)}, e1 = {bflo(ev.z), bfhi(ev.z), bflo(ev.w), bfhi(ev.w)};
                f32x4 s0 = acc[ai][bj][m][0], s1 = acc[ai][bj][m][1];
#pragma unroll
                for (int k = 0; k < 4; ++k) { s0[k] = sigm(s0[k]); s1[k] = sigm(s1[k]); }
                const u32x4 hv = hq[g][bj];
                const f32x4 h0 = {bflo(hv.x), bfhi(hv.x), bflo(hv.y), bfhi(hv.y)}, h1 = {bflo(hv.z), bfhi(hv.z), bflo(hv.w), bfhi(hv.w)};
                const f32x4 a0 = h0 + e0 * rE * gp[bj][0] * s0, a1 = h1 + e1 * rE * gp[bj][1] * s1;
                acc[ai][bj][m][0] = a0; acc[ai][bj][m][1] = a1;
                ss += (a0[0] * a0[0] + a0[1] * a0[1]) + (a0[2] * a0[2] + a0[3] * a0[3]) + (a1[0] * a1[0] + a1[1] * a1[1]) + (a1[2] * a1[2] + a1[3] * a1[3]); }
            ss += __shfl_xor(ss, 16); ss += __shfl_xor(ss, 32);
            if (fq == 0) __hip_atomic_fetch_add(ssq3 + row, ss, __ATOMIC_RELAXED, __HIP_MEMORY_SCOPE_AGENT);
            asm volatile("" ::: "memory"); }
#undef EGF_E
#undef EGF_H
        }
        asm volatile("s_waitcnt vmcnt(0)" ::: "memory");
        unsigned* pc = cnt + 64 * u.pm;
        if ((threadIdx.x & 63) == 0) __hip_atomic_fetch_add(pc, 1u, __ATOMIC_RELAXED, __HIP_MEMORY_SCOPE_AGENT);
        { unsigned sp = 0;
          while ((unsigned)__builtin_amdgcn_readfirstlane(__hip_atomic_load(pc, __ATOMIC_RELAXED, __HIP_MEMORY_SCOPE_AGENT)) < 32u) { __builtin_amdgcn_s_sleep(2); if (++sp > (1u << 22)) break; } }
        __builtin_amdgcn_fence(__ATOMIC_ACQUIRE, "agent");
        float s3[8];
#pragma unroll
        for (int g = 0; g < 8; ++g) s3[g] = __hip_atomic_load(ssq3 + row0 + (g >> 2) * HALF + (g & 3) * 16, __ATOMIC_RELAXED, __HIP_MEMORY_SCOPE_AGENT);
        f32x4 gf[2][2];
#pragma unroll
        for (int bj = 0; bj < 2; ++bj) { gf[bj][0] = *(const f32x4*)(gfin + col0 + bj * HALF); gf[bj][1] = *(const f32x4*)(gfin + col0 + bj * HALF + 4); }
#pragma unroll
        for (int ai = 0; ai < 2; ++ai)
#pragma unroll
            for (int m = 0; m < 4; ++m) { const int row = row0 + ai * HALF + m * 16;
                const float rs = __builtin_amdgcn_rsqf(s3[ai * 4 + m] * (1.0f / 1024.0f) + EPS_);
#pragma unroll
                for (int bj = 0; bj < 2; ++bj) { const size_t off = (size_t)row * 1024 + col0 + bj * HALF;
                    *(f32x4*)(out + off) = acc[ai][bj][m][0] * rs * gf[bj][0]; *(f32x4*)(out + off + 4) = acc[ai][bj][m][1] * rs * gf[bj][1]; }
                asm volatile("" ::: "memory"); }
    }
};

template <class Epi, class Sched, bool ALIGN_EPI = false, bool SP2 = false>
__device__ __forceinline__ void gemm_phase(PG8_LAS unsigned char* lds, const Gemm g, const Sched& S, const Epi& E) {
    const int tid = threadIdx.x, wid = __builtin_amdgcn_readfirstlane(tid >> 6), lane = tid & 63, wr = wid >> 2, wc = wid & 3, fr = lane & 15, fq = lane >> 4;
    const int K = g.K, nt = K / BK;
    unsigned voffA[2], voffB[2];
#pragma unroll
    for (int i = 0; i < 2; ++i) { int R, C; stage_rc(tid * 16 + i * 8192, R, C); const int Rb = Epi::PERM ? ((R & ~31) + perm32(R & 31)) : R;
        voffA[i] = (unsigned)(R * K + C) * 2u; voffB[i] = (unsigned)(Rb * K + C) * 2u; }
    const size_t kstep = (size_t)(BK * 2);
    const size_t hstep = (size_t)HALF * K * 2;
    const size_t tstep = 2 * hstep;
    const unsigned ldsw = (unsigned)wid * 1024u;
    const int aoff = lds_byte(wr * 64 + fr, fq * 8), boff = lds_byte(wc * 32 + fr, fq * 8);
#define PG8_SA(b, h) (((b) * 2 + (h)) * HTB)
#define PG8_SB(b, h) ((4 + (b) * 2 + (h)) * HTB)
#define PG8_STAGE(bufoff, gbase, voff) do { _Pragma("unroll") for (int _i = 0; _i < 2; ++_i) \
        __builtin_amdgcn_global_load_lds((const unsigned*)((const char*)(gbase) + (voff)[_i]), (PG8_LAS unsigned*)(lds + (bufoff) + ldsw + _i * 8192), 16, 0, 0); } while (0)
#define PG8_LDA(dst, b, h) do { _Pragma("unroll") for (int m = 0; m < 4; ++m) _Pragma("unroll") for (int k = 0; k < 2; ++k) dst[m][k] = *(const PG8_LAS bf16x8*)(lds + PG8_SA(b, h) + aoff + m * 2048 + k * 1024); } while (0)
#define PG8_LDB(dst, b, h) do { _Pragma("unroll") for (int n = 0; n < 2; ++n) _Pragma("unroll") for (int k = 0; k < 2; ++k) dst[n][k] = *(const PG8_LAS bf16x8*)(lds + PG8_SB(b, h) + boff + n * 2048 + k * 1024); } while (0)
#define PG8_MMA(ai, bj, At, Bt) do { __builtin_amdgcn_s_setprio(1); _Pragma("unroll") for (int m = 0; m < 4; ++m) _Pragma("unroll") for (int n = 0; n < 2; ++n) _Pragma("unroll") for (int k = 0; k < 2; ++k) \
        acc[ai][bj][m][n] = __builtin_amdgcn_mfma_f32_16x16x32_bf16(Bt[n][k], At[m][k], acc[ai][bj][m][n], 0, 0, 0); __builtin_amdgcn_s_setprio(0); } while (0)
#define PG8_WAIT_V(n) asm volatile("s_waitcnt vmcnt(" #n ")" ::: "memory")
#define PG8_WAIT_L(n) asm volatile("s_waitcnt lgkmcnt(" #n ")" ::: "memory")
#define PG8_BAR __builtin_amdgcn_s_barrier()
#define PG8_SCHED __builtin_amdgcn_sched_barrier(0)
    Unit cur, nxt; int ui = 0;
    if (!S.next(0, cur)) return;
    f32x4 acc[2][2][4][2];
#pragma unroll
    for (int a = 0; a < 2; ++a)
#pragma unroll
        for (int b = 0; b < 2; ++b)
#pragma unroll
            for (int m = 0; m < 4; ++m)
#pragma unroll
                for (int n = 0; n < 2; ++n) acc[a][b][m][n] = (f32x4){0.f, 0.f, 0.f, 0.f};
    bf16x8 At[4][2], B0[2][2], B1[2][2];
    const char* cA = (const char*)g.A + (size_t)cur.pm * tstep; const char* cB = (const char*)g.Bt + (size_t)cur.pn * tstep;
    S.a_ready(cur);
    if constexpr (SP2) {
        PG8_STAGE(PG8_SB(0, 0), cB, voffB); PG8_STAGE(PG8_SB(0, 1), cB + hstep, voffB); PG8_STAGE(PG8_SA(0, 0), cA, voffA); PG8_STAGE(PG8_SA(0, 1), cA + hstep, voffA);
        if (wr == 1) PG8_BAR;
        PG8_WAIT_V(2); PG8_BAR;
        PG8_STAGE(PG8_SB(1, 0), cB + kstep, voffB); PG8_STAGE(PG8_SA(1, 0), cA + kstep, voffA); PG8_STAGE(PG8_SB(1, 1), cB + hstep + kstep, voffB);
        PG8_WAIT_V(6); PG8_BAR;
    } else {
        PG8_STAGE(PG8_SB(0, 0), cB, voffB); PG8_STAGE(PG8_SA(0, 0), cA, voffA); PG8_STAGE(PG8_SB(0, 1), cB + hstep, voffB); PG8_STAGE(PG8_SA(0, 1), cA + hstep, voffA);
        if (wr == 1) PG8_BAR;
        PG8_WAIT_V(4); PG8_BAR;
        PG8_STAGE(PG8_SB(1, 0), cB + kstep, voffB); PG8_STAGE(PG8_SA(1, 0), cA + kstep, voffA); PG8_STAGE(PG8_SB(1, 1), cB + hstep + kstep, voffB);
        PG8_WAIT_V(6); PG8_BAR;
    }
    for (;;) {
        const bool has_next = S.next(ui + 1, nxt);
        const char* nA = has_next ? (const char*)g.A + (size_t)nxt.pm * tstep : cA; const char* nB = has_next ? (const char*)g.Bt + (size_t)nxt.pn * tstep : cB;
        for (int t = 0; t < nt; t += 2) {
            const bool last = (t == nt - 2);
            const char* a1 = cA + (size_t)(t + 1) * kstep;
            const char* a2 = last ? nA : cA + (size_t)(t + 2) * kstep; const char* b2 = last ? nB : cB + (size_t)(t + 2) * kstep;
            const char* a3 = a2 + kstep; const char* b3 = b2 + kstep;
            if (last && has_next) S.a_ready(nxt);
            if constexpr (SP2) {
            PG8_LDB(B0, 0, 0); PG8_LDB(B1, 0, 1); PG8_SCHED; PG8_LDA(At, 0, 0); PG8_STAGE(PG8_SA(1, 1), a1 + hstep, voffA);
            PG8_WAIT_V(8); PG8_WAIT_L(0); PG8_BAR; PG8_MMA(0, 0, At, B0); PG8_MMA(0, 1, At, B1); PG8_BAR; PG8_SCHED;
            PG8_LDA(At, 0, 1); PG8_STAGE(PG8_SB(0, 0), b2, voffB); PG8_STAGE(PG8_SB(0, 1), b2 + hstep, voffB); PG8_STAGE(PG8_SA(0, 0), a2, voffA);
            PG8_WAIT_V(8); PG8_WAIT_L(0); PG8_BAR; PG8_MMA(1, 0, At, B0); PG8_MMA(1, 1, At, B1); PG8_BAR; PG8_SCHED;
            PG8_LDB(B0, 1, 0); PG8_LDB(B1, 1, 1); PG8_SCHED; PG8_LDA(At, 1, 0); PG8_STAGE(PG8_SA(0, 1), a2 + hstep, voffA);
            PG8_WAIT_V(8); PG8_WAIT_L(0); PG8_BAR; PG8_MMA(0, 0, At, B0); PG8_MMA(0, 1, At, B1); PG8_BAR; PG8_SCHED;
            PG8_LDA(At, 1, 1); PG8_STAGE(PG8_SB(1, 0), b3, voffB); PG8_STAGE(PG8_SB(1, 1), b3 + hstep, voffB); PG8_STAGE(PG8_SA(1, 0), a3, voffA);
            PG8_WAIT_V(8); PG8_WAIT_L(0); PG8_BAR; PG8_MMA(1, 0, At, B0); PG8_MMA(1, 1, At, B1); PG8_BAR; PG8_SCHED;
            } else {
            PG8_LDB(B0, 0, 0); PG8_SCHED; PG8_LDA(At, 0, 0); PG8_STAGE(PG8_SA(1, 1), a1 + hstep, voffA);
            PG8_WAIT_L(8); PG8_BAR; PG8_WAIT_L(0); PG8_MMA(0, 0, At, B0); PG8_BAR; PG8_SCHED;
            PG8_LDB(B1, 0, 1); PG8_STAGE(PG8_SB(0, 0), b2, voffB);
            PG8_BAR; PG8_WAIT_L(0); PG8_MMA(0, 1, At, B1); PG8_BAR;
            PG8_LDA(At, 0, 1); PG8_STAGE(PG8_SA(0, 0), a2, voffA);
            PG8_BAR; PG8_WAIT_L(0); PG8_MMA(1, 0, At, B0); PG8_BAR; PG8_SCHED;
            PG8_STAGE(PG8_SB(0, 1), b2 + hstep, voffB);
            PG8_WAIT_V(6); PG8_BAR; PG8_MMA(1, 1, At, B1); PG8_BAR;
            PG8_LDB(B0, 1, 0); PG8_SCHED; PG8_LDA(At, 1, 0); PG8_STAGE(PG8_SA(0, 1), a2 + hstep, voffA);
            PG8_WAIT_L(8); PG8_BAR; PG8_WAIT_L(0); PG8_MMA(0, 0, At, B0); PG8_BAR; PG8_SCHED;
            PG8_LDB(B1, 1, 1); PG8_STAGE(PG8_SB(1, 0), b3, voffB);
            PG8_BAR; PG8_WAIT_L(0); PG8_MMA(0, 1, At, B1); PG8_BAR;
            PG8_LDA(At, 1, 1); PG8_STAGE(PG8_SA(1, 0), a3, voffA);
            PG8_BAR; PG8_WAIT_L(0); PG8_MMA(1, 0, At, B0); PG8_BAR; PG8_SCHED;
            PG8_STAGE(PG8_SB(1, 1), b3 + hstep, voffB);
            PG8_WAIT_V(6); PG8_BAR; PG8_MMA(1, 1, At, B1); PG8_BAR;
            }
        }
        if constexpr (ALIGN_EPI) { if (wr == 0) PG8_BAR; }
        if constexpr (!Epi::AFTER_DRAIN) { E(acc, cur, wr, wc, fr, fq); S.done(cur); }
        if (!has_next) break;
#pragma unroll
        for (int a = 0; a < 2; ++a)
#pragma unroll
            for (int b = 0; b < 2; ++b)
#pragma unroll
                for (int m = 0; m < 4; ++m)
#pragma unroll
                    for (int n = 0; n < 2; ++n) acc[a][b][m][n] = (f32x4){0.f, 0.f, 0.f, 0.f};
        cur = nxt; cA = nA; cB = nB; ++ui;
        if constexpr (ALIGN_EPI) { if (wr == 1) PG8_BAR; }
    }
    PG8_WAIT_V(0);
    if constexpr (!ALIGN_EPI) { if (wr == 0) PG8_BAR; }
    PG8_BAR;
    if constexpr (Epi::AFTER_DRAIN) { E.fused(acc, cur, wr, wc, fr, fq, lds, wid, lane); S.done(cur); }
#undef PG8_SA
#undef PG8_SB
#undef PG8_STAGE
#undef PG8_LDA
#undef PG8_LDB
#undef PG8_MMA
#undef PG8_WAIT_V
#undef PG8_WAIT_L
#undef PG8_BAR
#undef PG8_SCHED
}
}

#define LAS __attribute__((address_space(3)))
typedef unsigned short bf16_t;
typedef short bf16x8 __attribute__((ext_vector_type(8)));
typedef float f32x4 __attribute__((ext_vector_type(4)));
typedef unsigned u32x4 __attribute__((ext_vector_type(4)));
typedef unsigned u32x2 __attribute__((ext_vector_type(2)));
using pg8::cvt_pk_bf16; using pg8::bflo; using pg8::bfhi; using pg8::sigm; using pg8::f32x2_t;

#ifndef MK_COOP
#define MK_COOP 1
#endif
constexpr int NWAVES = 8, NTHR = 512;
constexpr int BATCH = 8, SEQ = 4096, D = 1024, M = BATCH * SEQ, DIN = 3072, FF = 4096, PLE = 256, DC = 512, DR = 512, NH = 4, HD = 128, CH = 64, NCHUNK = SEQ / CH;
constexpr int NUNIT = BATCH * NH * NCHUNK;
constexpr float EPS = 1e-6f;
constexpr int N_PHASES = 9;
constexpr size_t MiB = 1u << 20;
constexpr size_t WS_PCNT = 576 * 1024;
constexpr size_t WS_BAR = 512 * 1024;
constexpr size_t WS_RSTD1 = 0, WS_SSQ2 = 128 * 1024, WS_SSQE = 256 * 1024, WS_SSQ3 = 384 * 1024, WS_DEC = 1 * MiB;
constexpr size_t WS_WIN = 2 * MiB, WS_WOUT = 8 * MiB, WS_WUP = 10 * MiB, WS_WDOWN = 18 * MiB, WS_WPLE = 26 * MiB, WS_WGATE = 27 * MiB;
constexpr size_t WS_XB = 32 * MiB;
constexpr size_t WS_PB = 96 * MiB;
constexpr size_t WS_CGLU = 112 * MiB, WS_QB = 144 * MiB, WS_GS = 176 * MiB, WS_LOGF = 208 * MiB, WS_VB = 272 * MiB, WS_UT = 304 * MiB;
constexpr size_t WS_T = 112 * MiB;
constexpr size_t WS_Y = 368 * MiB;
constexpr size_t WS_E = 432 * MiB;
constexpr size_t WS_ASEG = 496 * MiB, WS_ESEG = 504 * MiB;
constexpr size_t WS_DSEG = 29 * MiB;
constexpr size_t WS_END = 512 * MiB;
constexpr int LDS_BYTES = 147456;

__device__ __forceinline__ float wave_sum(float v) {
#pragma unroll
    for (int o = 1; o < 64; o <<= 1) v += __shfl_xor(v, o);
    return v;
}
#define LDS_WAIT() asm volatile("s_waitcnt lgkmcnt(0)" ::: "memory")

__device__ __forceinline__ void transpose_item(const float* W, int K, int N, bf16_t* WT, int mode, const float* gain, LAS float* scr, int item, int lane) {
    const int nblk = N / 32, kb = item / nblk, nb = item % nblk, k0 = 64 * kb, n0 = 32 * nb;
#pragma unroll 8
    for (int i = 0; i < 32; ++i) { const int kk = 2 * i + (lane >> 5); float w = __builtin_nontemporal_load(W + (size_t)(k0 + kk) * N + n0 + (lane & 31)); if (gain) w *= gain[k0 + kk]; scr[kk * 33 + (lane & 31)] = w; }
    LDS_WAIT();
    int drow0 = n0;
    if (mode == 1) { const int region = n0 >> 9, within = n0 & 511, j = within >> 7, c0 = within & 127;
        int tile, bj;
        switch (region) { case 0: tile = j; bj = 0; break; case 1: tile = j; bj = 1; break; case 2: tile = 4 + j; bj = 0; break;
                          case 3: tile = 8 + j; bj = 0; break; case 4: tile = 8 + j; bj = 1; break; default: tile = 4 + j; bj = 1; break; }
        drow0 = tile * 256 + bj * 128 + c0; }
    const int c = lane & 7;
#pragma unroll
    for (int j = 0; j < 4; ++j) { const int n = (lane >> 3) + 8 * j; const LAS float* s = scr + (8 * c) * 33 + n;
        u32x4 o; o.x = cvt_pk_bf16(s[0 * 33], s[1 * 33]); o.y = cvt_pk_bf16(s[2 * 33], s[3 * 33]); o.z = cvt_pk_bf16(s[4 * 33], s[5 * 33]); o.w = cvt_pk_bf16(s[6 * 33], s[7 * 33]);
        *(u32x4*)(WT + (size_t)(drow0 + n) * K + k0 + 8 * c) = o; }
    LDS_WAIT();
}

typedef __attribute__((address_space(1))) unsigned gu32;
#define XB_TMO      128
#define XB_XCNT(j)  (256  + 64 * (j))
#define XB_XSUB(j)  (1280 + 64 * (j))
#define XB_XGEN(j)  (2304 + 64 * (j))
#define XB_TOP      3328
#define XB_TOPGEN   3392
#define XCD_BAR_WORDS 3456
#define XB_SPIN_CAP (1u << 18)

__device__ __forceinline__ unsigned xb_ld(unsigned* p)              { return __hip_atomic_load(p, __ATOMIC_RELAXED, __HIP_MEMORY_SCOPE_AGENT); }
__device__ __forceinline__ unsigned xb_add(unsigned* p, unsigned v) { return __hip_atomic_fetch_add(p, v, __ATOMIC_RELAXED, __HIP_MEMORY_SCOPE_AGENT); }
__device__ __forceinline__ unsigned xb_xcc_id() { return (unsigned)__builtin_amdgcn_s_getreg((3 << 11) | 20) & 0xFu; }
#define XB_SPIN(cond, bar) do { unsigned _sp = 0; while (cond) { __builtin_amdgcn_s_sleep(1); \
    if ((++_sp & 255u) == 0u) { if (xb_ld(&(bar)[XB_TMO])) break; if (_sp > XB_SPIN_CAP) { atomicAdd(&(bar)[XB_TMO], 1u); break; } } } } while (0)

struct XcdBarrier {
    unsigned* bar; unsigned x;
    volatile LAS unsigned* st;
};

__device__ __forceinline__ XcdBarrier xcd_barrier_post(unsigned* bar, volatile LAS unsigned* st) {
    XcdBarrier b; b.bar = bar; b.x = xb_xcc_id(); b.st = st;
    if (threadIdx.x == 0) (void)xb_add(&bar[XB_XCNT(b.x)], 1u);
    return b;
}
__device__ __forceinline__ void xcd_barrier_complete(unsigned* bar, unsigned x, unsigned& nloc, unsigned& nx) {
    const unsigned G = gridDim.x * gridDim.y * gridDim.z;
    unsigned sum, cnt, mine, sp = 0u;
    for (;;) {
        sum = 0u; cnt = 0u; mine = 0u;
#pragma unroll
        for (unsigned j = 0; j < 16; ++j) { const unsigned c = xb_ld(&bar[XB_XCNT(j)]); sum += c; cnt += (c > 0u) ? 1u : 0u; mine = (j == x) ? c : mine; }
        if (sum == G) break;
        __builtin_amdgcn_s_sleep(1);
        if ((++sp & 255u) == 0u) { if (xb_ld(&bar[XB_TMO])) break; if (sp > XB_SPIN_CAP) { atomicAdd(&bar[XB_TMO], 1u); break; } }
    }
    nloc = mine > 0u ? mine : 1u; nx = cnt > 0u ? cnt : 1u;
}

__device__ __forceinline__ void xcd_barrier(const XcdBarrier& b) {
    asm volatile("s_waitcnt vmcnt(0)" ::: "memory");
    __syncthreads();
    if (threadIdx.x == 0) {
        unsigned* bar = b.bar;
        __builtin_amdgcn_s_waitcnt(0);
        unsigned nloc = b.st[0], nx = b.st[1];
        if (nloc == 0u) { xcd_barrier_complete(bar, b.x, nloc, nx); b.st[0] = nloc; b.st[1] = nx; }
        const unsigned old = xb_add(&bar[XB_XSUB(b.x)], 1u);
        const unsigned gen = old / nloc;
        if (old + 1u == (gen + 1u) * nloc) {
            __builtin_amdgcn_fence(__ATOMIC_RELEASE, "agent");
            asm volatile("s_waitcnt vmcnt(0)" ::: "memory");
            const unsigned og = xb_add(&bar[XB_TOP], 1u);
            const unsigned tg = og / nx;
            if (og + 1u == (tg + 1u) * nx) xb_add(&bar[XB_TOPGEN], 1u);
            else XB_SPIN(xb_ld(&bar[XB_TOPGEN]) == tg, bar);
            __builtin_amdgcn_fence(__ATOMIC_ACQUIRE, "agent");
            xb_add(&bar[XB_XGEN(b.x)], 1u);
            asm volatile("s_waitcnt vmcnt(0)" ::: "memory");
        } else {
            XB_SPIN(xb_ld(&bar[XB_XGEN(b.x)]) == gen, bar);
            __builtin_amdgcn_fence(__ATOMIC_ACQUIRE, "agent");
            asm volatile("s_waitcnt vmcnt(0)" ::: "memory");
        }
    }
    __syncthreads();
}

struct Args { const float* in[18]; float* out; unsigned char* ws; int ph_lo, ph_hi; };

__global__ void __launch_bounds__(NTHR, 2) mk_fwd(Args args) {
    extern __shared__ __attribute__((aligned(16))) unsigned char lds_raw[];
    LAS unsigned char* lds = (LAS unsigned char*)lds_raw;
    cg::grid_group grid = cg::this_grid();
    const int tid = threadIdx.x, lane = tid & 63, wave = __builtin_amdgcn_readfirstlane(tid >> 6);
    const int G = gridDim.x, gw = blockIdx.x * NWAVES + wave, NGW = G * NWAVES;
    const int lo = args.ph_lo, hi = args.ph_hi;
    unsigned char* const ws = args.ws;
#define xin (args.in[0])
#define outp (args.out)
#define rstd1 ((float*)(ws + WS_RSTD1))
#define ssq2 ((float*)(ws + WS_SSQ2))
#define ssqE ((float*)(ws + WS_SSQE))
#define ssq3 ((float*)(ws + WS_SSQ3))
#define dec ((float*)(ws + WS_DEC))
#define WinT ((bf16_t*)(ws + WS_WIN))
#define WoutT ((bf16_t*)(ws + WS_WOUT))
#define WupT ((bf16_t*)(ws + WS_WUP))
#define WdownT ((bf16_t*)(ws + WS_WDOWN))
#define WpleT ((bf16_t*)(ws + WS_WPLE))
#define WgateT ((bf16_t*)(ws + WS_WGATE))
#define xb ((bf16_t*)(ws + WS_XB))
#define pb ((bf16_t*)(ws + WS_PB))
#define cglu ((bf16_t*)(ws + WS_CGLU))
#define qb ((bf16_t*)(ws + WS_QB))
#define gs ((bf16_t*)(ws + WS_GS))
#define logf ((_Float16*)(ws + WS_LOGF))
#define vb ((bf16_t*)(ws + WS_VB))
#define Ut ((bf16_t*)(ws + WS_UT))
#define tb ((bf16_t*)(ws + WS_T))
#define yb ((bf16_t*)(ws + WS_Y))
#define eb ((bf16_t*)(ws + WS_E))
#define Aseg ((bf16_t*)(ws + WS_ASEG))
#define Eseg ((bf16_t*)(ws + WS_ESEG))
#define Dseg ((float*)(ws + WS_DSEG))
#define IN(k) (lo <= (k) && (k) < hi)
#ifndef DBG_TS
#define DBG_TS -1
#endif
    volatile LAS unsigned* bar_st = (volatile LAS unsigned*)(lds + 147328 + 64);
    if (tid < 2) bar_st[tid] = 0u;
    __syncthreads();
    XcdBarrier bar; bar.bar = (unsigned*)(ws + WS_BAR); bar.x = 0; bar.st = bar_st;
    if (hi - lo > 1) bar = xcd_barrier_post((unsigned*)(ws + WS_BAR), bar_st);
    volatile LAS unsigned long long* tsw = (volatile LAS unsigned long long*)(lds + 147328);
    if (DBG_TS >= 0 && tid == 0) { tsw[0] = __builtin_amdgcn_s_memrealtime(); tsw[1] = 0ull; }
#define SEAM(k) do { if (IN(k) && IN((k) + 1)) { if (hi > N_PHASES) grid.sync(); else xcd_barrier(bar); } if (DBG_TS >= 0 && tid == 0) { const unsigned long long t_ = __builtin_amdgcn_s_memrealtime(); if ((k) == DBG_TS) tsw[1] = t_ - tsw[0]; tsw[0] = t_; } } while (0)

#define TSMARK(id) do { if (DBG_TS == (id) && tid == 0) tsw[1] = __builtin_amdgcn_s_memrealtime() - tsw[0]; } while (0)
    if (IN(0)) {
        LAS float* scr = (LAS float*)(lds + wave * 16384);
        constexpr int I_IN = (D / 64) * (DIN / 32);
        for (int it = gw; it < I_IN; it += NGW) transpose_item(args.in[3], D, DIN, WinT, 1, args.in[2], scr, it, lane);
        for (int m0 = gw; m0 < M; m0 += 2 * NGW) {
            f32x4 v[2][4];
#pragma unroll
            for (int r = 0; r < 2; ++r) { const int m = m0 + r * NGW; const f32x4* xr = (const f32x4*)(xin + (size_t)m * D) + lane;
#pragma unroll
                for (int j = 0; j < 4; ++j) v[r][j] = __builtin_nontemporal_load(xr + 64 * j); }
#pragma unroll
            for (int r = 0; r < 2; ++r) { const int m = m0 + r * NGW; float sq = 0.f;
#pragma unroll
                for (int j = 0; j < 4; ++j) sq += (v[r][j][0] * v[r][j][0] + v[r][j][1] * v[r][j][1]) + (v[r][j][2] * v[r][j][2] + v[r][j][3] * v[r][j][3]);
                sq = wave_sum(sq);
                if (lane == 0) rstd1[m] = sqrtf(sq * (1.0f / D) + EPS);
                u32x2* o8 = (u32x2*)(xb + (size_t)m * D) + lane;
                const float rs_ = __builtin_amdgcn_rsqf(sq * (1.0f / D) + EPS);
#pragma unroll
                for (int j = 0; j < 4; ++j) { u32x2 w; w.x = cvt_pk_bf16(v[r][j][0] * rs_, v[r][j][1] * rs_); w.y = cvt_pk_bf16(v[r][j][2] * rs_, v[r][j][3] * rs_); o8[64 * j] = w; } }
        }
        for (int i = blockIdx.x * NTHR + tid; i < M; i += G * NTHR) { ssq2[i] = 0.f; ssqE[i] = 0.f; ssq3[i] = 0.f; }
        __syncthreads();
    }
    SEAM(0);

    if (IN(1)) {
        { pg8::Gemm g{xb, WinT, M, DIN, D}; pg8::StaticOrder S; S.init(M, DIN, G, (int)blockIdx.x);
          pg8::EpiIn E{rstd1, args.in[8], cglu, qb, gs, logf, vb};
          pg8::gemm_phase<pg8::EpiIn, pg8::StaticOrder, true, true>(lds, g, S, E); }
    }
    SEAM(1);

    if (IN(2)) {
        {
            LAS float* scr = (LAS float*)(lds + wave * 15872);
            constexpr int I_OUT = (D / 64) * (D / 32), I_UP = (D / 64) * (FF / 32), I_DOWN = (FF / 64) * (D / 32), I_PLE = (PLE / 64) * (D / 32), I_GATE = I_OUT;
            constexpr int NIT2 = I_OUT + I_UP + I_DOWN + I_PLE + I_GATE;
            for (int it = gw; it < NIT2; it += NGW) {
                int r = it;
                if (r < I_OUT) { transpose_item(args.in[10], D, D, WoutT, 0, nullptr, scr, r, lane); continue; } r -= I_OUT;
                if (r < I_UP) { transpose_item(args.in[12], D, FF, WupT, 0, args.in[11], scr, r, lane); continue; } r -= I_UP;
                if (r < I_DOWN) { transpose_item(args.in[13], FF, D, WdownT, 0, nullptr, scr, r, lane); continue; } r -= I_DOWN;
                if (r < I_PLE) { transpose_item(args.in[14], PLE, D, WpleT, 0, nullptr, scr, r, lane); continue; } r -= I_PLE;
                transpose_item(args.in[16], D, D, WgateT, 0, nullptr, scr, r, lane);
            }
            for (int m0 = gw; m0 < M; m0 += 4 * NGW) {
                f32x4 pv[4];
#pragma unroll
                for (int r = 0; r < 4; ++r) pv[r] = __builtin_nontemporal_load((const f32x4*)(args.in[1] + (size_t)(m0 + r * NGW) * PLE) + lane);
#pragma unroll
                for (int r = 0; r < 4; ++r) { u32x2 w; w.x = cvt_pk_bf16(pv[r][0], pv[r][1]); w.y = cvt_pk_bf16(pv[r][2], pv[r][3]); *((u32x2*)(pb + (size_t)(m0 + r * NGW) * PLE) + lane) = w; }
            }
        }
        {
            typedef float f32x2 __attribute__((ext_vector_type(2)));
            LAS bf16_t* Xs = (LAS bf16_t*)(lds + wave * 15872);
            const float* cw = args.in[4]; const float* cbias = args.in[5]; const float* lng = args.in[6]; const float* lnb = args.in[7];
            const int cb = gw & 3, ch = cb * 128 + 2 * lane;
            f32x2 wj[31];
#pragma unroll
            for (int j = 0; j < 31; ++j) wj[j] = *(const f32x2*)(cw + j * DC + ch);
            const f32x2 bias = *(const f32x2*)(cbias + ch), gg = *(const f32x2*)(lng + ch), bb = *(const f32x2*)(lnb + ch);
            for (int uidx = gw; uidx < (M / 32) * 4; uidx += NGW) {
                const int tile = uidx >> 2, b = tile >> 7, t0 = (tile & 127) * 32;
                const int rr = lane >> 4, c16 = lane & 15;
#pragma unroll 4
                for (int it = 0; it < 16; ++it) { const int i = it * 4 + rr; const int t = t0 - 30 + i;
                    if (i < 62) { u32x4 v = {0u, 0u, 0u, 0u}; if (t >= 0) v = __builtin_nontemporal_load((const u32x4*)(cglu + ((size_t)b * SEQ + t) * DC + cb * 128 + c16 * 8));
                        *(LAS u32x4*)(Xs + i * 128 + c16 * 8) = v; } }
                LDS_WAIT();
                for (int tblk = 0; tblk < 8; ++tblk) {
                    f32x2 xs[34];
#pragma unroll
                    for (int i = 0; i < 34; ++i) { const unsigned w = *(const LAS unsigned*)(Xs + (tblk * 4 + i) * 128 + 2 * lane); xs[i] = (f32x2){bflo(w), bfhi(w)}; }
                    f32x2 av[4]; float s1[4], s2[4];
#pragma unroll
                    for (int o = 0; o < 4; ++o) { f32x2 a = bias;
#pragma unroll
                        for (int j = 0; j < 31; ++j) a = __builtin_elementwise_fma(wj[j], xs[o + j], a);
                        av[o] = a; s1[o] = a.x + a.y; s2[o] = a.x * a.x + a.y * a.y; }
#pragma unroll
                    for (int st = 1; st < 32; st <<= 1) {
#pragma unroll
                        for (int o = 0; o < 4; ++o) { s1[o] += __shfl_xor(s1[o], st); s2[o] += __shfl_xor(s2[o], st); } }
#pragma unroll
                    for (int o = 0; o < 4; ++o) { const float mu = s1[o] * (1.0f / 64.0f); const float var = fmaxf(s2[o] * (1.0f / 64.0f) - mu * mu, 0.f);
                        const float rs = __builtin_amdgcn_rsqf(var + EPS);
                        f32x2 yv = (av[o] - mu) * rs * gg + bb; yv.x = yv.x * sigm(yv.x); yv.y = yv.y * sigm(yv.y);
                        *(unsigned*)(yb + ((size_t)b * SEQ + t0 + tblk * 4 + o) * D + ch) = cvt_pk_bf16(yv.x, yv.y); }
                }
                LDS_WAIT();
            }
        }
        __syncthreads();
        {
            LAS bf16_t* Kt = (LAS bf16_t*)(lds);
            LAS bf16_t* Vt = (LAS bf16_t*)(lds + 18432);
            LAS float* PT = (LAS float*)(lds + 57344);
            LAS float* DEC = (LAS float*)(lds + 38912);
            LAS _Float16* RawLF = (LAS _Float16*)(lds + 40960);
            const int dp = tid & 63, part = tid >> 6, l15 = lane & 15, lq = lane >> 4;
            typedef _Float16 h2v __attribute__((ext_vector_type(2)));
            u32x4 lfr[2], vvn[2];
#define H1_LOAD(unit_) do { const int c_ = (unit_) & 63, bh_ = (unit_) >> 6, h_ = bh_ & 3, b_ = bh_ >> 2; const size_t r0_ = (size_t)b_ * SEQ + 64 * c_; \
                _Pragma("unroll") for (int it = 0; it < 2; ++it) { const int idx = tid + 512 * it; lfr[it] = *(const u32x4*)(logf + (r0_ + (idx >> 4)) * DR + h_ * HD + (idx & 15) * 8); } \
                _Pragma("unroll") for (int it = 0; it < 2; ++it) { const int idx = tid + 512 * it, s = idx >> 4, e8 = idx & 15; vvn[it] = *(const u32x4*)(vb + (r0_ + s) * DR + h_ * HD + e8 * 8); } } while (0)
            const int segid = (int)blockIdx.x;
            const int unit0 = ((segid >> 3) << 6) | ((segid & 7) << 3);
            f32x4 Srun[8];
#pragma unroll
            for (int et = 0; et < 8; ++et) Srun[et] = (f32x4){0.f, 0.f, 0.f, 0.f};
            float dpre0 = 1.0f, dpre1 = 1.0f;
            const int d0 = 16 * wave;
            if (segid < BATCH * NH * 8) {
            H1_LOAD(unit0);
            for (int k = 0; k < 8; ++k) { const int unit = unit0 + k;
                float lf[16]; u32x4 vv[2];
#pragma unroll
                for (int it = 0; it < 2; ++it) { const int idx = tid + 512 * it; *(LAS u32x4*)(RawLF + (idx >> 4) * 128 + (idx & 15) * 8) = lfr[it]; }
                vv[0] = vvn[0]; vv[1] = vvn[1];
#pragma unroll
                for (int it = 0; it < 2; ++it) { const int idx = tid + 512 * it, s = idx >> 4, e8 = idx & 15;
#pragma unroll
                    for (int j = 0; j < 4; ++j) { const unsigned w = vv[it][j]; Vt[(e8 * 8 + 2 * j) * 72 + (s ^ ((e8 & 7) << 3))] = (bf16_t)(w & 0xffffu); Vt[(e8 * 8 + 2 * j + 1) * 72 + (s ^ ((e8 & 7) << 3))] = (bf16_t)(w >> 16); } }
                if (k + 1 < 8) H1_LOAD(unit + 1);
                __syncthreads();
                float lf0[8], lf1[8], bc0[8], bc1[8]; float run0 = 0.f, run1 = 0.f;
#pragma unroll
                for (int i = 0; i < 8; ++i) { const f32x2_t v2 = __builtin_convertvector(__builtin_bit_cast(h2v, *(const LAS unsigned*)(RawLF + (8 * part + i) * 128 + 2 * dp)), f32x2_t);
                    lf0[i] = v2.x; lf1[i] = v2.y; run0 += v2.x; run1 += v2.y; bc0[i] = run0; bc1[i] = run1; }
                *(LAS f32x2_t*)(PT + part * 128 + 2 * dp) = (f32x2_t){run0, run1};
                __syncthreads();
                float off0 = 0.f, off1 = 0.f;
#pragma unroll
                for (int p = 0; p < 7; ++p) if (p < part) { const f32x2_t pv = *(const LAS f32x2_t*)(PT + p * 128 + 2 * dp); off0 += pv.x; off1 += pv.y; }
                unsigned k0w[4], k1w[4];
#pragma unroll
                for (int i = 0; i < 8; i += 2) { const float ba = bc0[i] + off0, bb_ = bc0[i + 1] + off0, bc_ = bc1[i] + off1, bd = bc1[i + 1] + off1;
                    k0w[i >> 1] = cvt_pk_bf16((1.0f - __expf(lf0[i])) * __expf(-ba), (1.0f - __expf(lf0[i + 1])) * __expf(-bb_));
                    k1w[i >> 1] = cvt_pk_bf16((1.0f - __expf(lf1[i])) * __expf(-bc_), (1.0f - __expf(lf1[i + 1])) * __expf(-bd)); }
                *(LAS u32x4*)(Kt + (2 * dp) * 72 + 8 * part) = (u32x4){k0w[0], k0w[1], k0w[2], k0w[3]};
                *(LAS u32x4*)(Kt + (2 * dp + 1) * 72 + 8 * part) = (u32x4){k1w[0], k1w[1], k1w[2], k1w[3]};
                if (part == 7) { const float dc0 = __expf(bc0[7] + off0), dc1 = __expf(bc1[7] + off1); *(LAS f32x2_t*)(DEC + 2 * dp) = (f32x2_t){dc0, dc1}; dpre0 *= dc0; dpre1 *= dc1; }
                __syncthreads();
                bf16x8 a[2];
#pragma unroll
                for (int kk = 0; kk < 2; ++kk) a[kk] = *(const LAS bf16x8*)(Kt + (d0 + l15) * 72 + 8 * lq + 32 * kk);
                const f32x4 dv = *(const LAS f32x4*)(DEC + d0 + 4 * lq);
#pragma unroll
                for (int et = 0; et < 8; ++et) { f32x4 acc = {0.f, 0.f, 0.f, 0.f};
#pragma unroll
                    for (int kk = 0; kk < 2; ++kk) { const bf16x8 bf = *(const LAS bf16x8*)(Vt + (16 * et + l15) * 72 + 8 * ((lq + 4 * kk) ^ ((2 * et + (l15 >> 3)) & 7))); acc = __builtin_amdgcn_mfma_f32_16x16x32_bf16(a[kk], bf, acc, 0, 0, 0); }
                    Srun[et] = dv * (Srun[et] + acc); }
                __syncthreads();
            }
#pragma unroll
            for (int et = 0; et < 8; ++et) { u32x2 w2; w2.x = cvt_pk_bf16(Srun[et][0], Srun[et][1]); w2.y = cvt_pk_bf16(Srun[et][2], Srun[et][3]);
                *(u32x2*)(Aseg + (size_t)segid * (HD * HD) + (16 * et + l15) * HD + d0 + 4 * lq) = w2; }
            if (part == 7) *(f32x2_t*)(Dseg + segid * HD + 2 * dp) = (f32x2_t){dpre0, dpre1};
            }
        }
    }
    SEAM(2);

    if (IN(3)) {
        for (int idx = blockIdx.x * NTHR + tid; idx < BATCH * NH * HD * (HD / 4); idx += G * NTHR) {
            const int bh = idx >> 12, el = idx & 4095, d4 = el & 31;
            float E0 = 0.f, E1 = 0.f, E2 = 0.f, E3 = 0.f;
#pragma unroll
            for (int j = 0; j < 8; ++j) { const size_t o = (size_t)(bh * 8 + j) * (HD * HD) + (size_t)el * 4;
                const u32x2 av = *(const u32x2*)(Aseg + o); const f32x4 dv = *(const f32x4*)(Dseg + (bh * 8 + j) * HD + d4 * 4);
                u32x2 sv; sv.x = cvt_pk_bf16(E0, E1); sv.y = cvt_pk_bf16(E2, E3); *(u32x2*)(Eseg + o) = sv;
                E0 = bflo(av.x) + dv[0] * E0; E1 = bfhi(av.x) + dv[1] * E1; E2 = bflo(av.y) + dv[2] * E2; E3 = bfhi(av.y) + dv[3] * E3; }
        }
    }
    SEAM(3);

    if (IN(4)) {
        LAS bf16_t* Qs = (LAS bf16_t*)(lds);
        LAS bf16_t* Ks = (LAS bf16_t*)(lds + 17408);
        LAS bf16_t* Vt = (LAS bf16_t*)(lds + 34816);
        LAS bf16_t* St = (LAS bf16_t*)(lds + 53248);
        LAS bf16_t* As = (LAS bf16_t*)(lds + 88064);
        LAS float* PT = (LAS float*)(lds + 135168);
        LAS float* SS = (LAS float*)(lds + 99328);
        LAS _Float16* RawLF = (LAS _Float16*)(lds);
        LAS bf16_t* RawQ = (LAS bf16_t*)(lds + 99840);
        LAS bf16_t* Kt = (LAS bf16_t*)(lds + 116224);
        LAS float* DEC = (LAS float*)(lds + 134656);
        const float* recg = args.in[9];
        const int dp = tid & 63, part = tid >> 6, l15 = lane & 15, lq = lane >> 4;
        typedef _Float16 h2v __attribute__((ext_vector_type(2)));
        u32x4 lfr[2], qr[2], vvn[2]; u32x2 gvn[4]; f32x4 rgn[4];
        const int o_tt = wave & 3, o_eh = wave >> 2;
#define H3_LOAD(unit_) do { const int c_ = (unit_) & 63, bh_ = (unit_) >> 6, h_ = bh_ & 3, b_ = bh_ >> 2; const size_t r0_ = (size_t)b_ * SEQ + 64 * c_; \
            _Pragma("unroll") for (int it = 0; it < 2; ++it) { const int idx = tid + 512 * it; lfr[it] = __builtin_nontemporal_load((const u32x4*)(logf + (r0_ + (idx >> 4)) * DR + h_ * HD + (idx & 15) * 8)); } \
            _Pragma("unroll") for (int it = 0; it < 2; ++it) { const int idx = tid + 512 * it; qr[it] = __builtin_nontemporal_load((const u32x4*)(qb + (r0_ + (idx >> 4)) * DR + h_ * HD + (idx & 15) * 8)); } \
            _Pragma("unroll") for (int it = 0; it < 2; ++it) { const int idx = tid + 512 * it, s = idx >> 4, e8 = idx & 15; vvn[it] = __builtin_nontemporal_load((const u32x4*)(vb + (r0_ + s) * DR + h_ * HD + e8 * 8)); } \
            _Pragma("unroll") for (int et = 0; et < 4; ++et) { const int e_ = 16 * (4 * o_eh + et) + 4 * lq; gvn[et] = __builtin_nontemporal_load((const u32x2*)(gs + (r0_ + 16 * o_tt + l15) * DR + h_ * HD + e_)); } } while (0)
        const int segid = (int)blockIdx.x, unit0 = ((segid >> 3) << 6) | ((segid & 7) << 3);
        if (segid < BATCH * NH * 8) {
        const int d0 = 16 * wave;
        f32x4 Srun[8];
#pragma unroll
        for (int et = 0; et < 8; ++et) { const u32x2 ev = *(const u32x2*)(Eseg + (size_t)segid * (HD * HD) + (16 * et + l15) * HD + d0 + 4 * lq); Srun[et] = (f32x4){bflo(ev.x), bfhi(ev.x), bflo(ev.y), bfhi(ev.y)}; }
#pragma unroll
        for (int et = 0; et < 4; ++et) rgn[et] = *(const f32x4*)(recg + ((segid >> 3) & 3) * HD + 16 * (4 * o_eh + et) + 4 * lq);
        H3_LOAD(unit0);
        for (int k8 = 0; k8 < 8; ++k8) { const int unit = unit0 + k8;
            const int c = unit & 63, bh = unit >> 6, h = bh & 3, b = bh >> 2; const size_t r0 = (size_t)b * SEQ + 64 * c;
            float lf[16]; float qv[16]; u32x4 vv[2];
#pragma unroll
            for (int it = 0; it < 2; ++it) { const int idx = tid + 512 * it; *(LAS u32x4*)(RawLF + (idx >> 4) * 128 + (idx & 15) * 8) = lfr[it]; }
#pragma unroll
            for (int it = 0; it < 2; ++it) { const int idx = tid + 512 * it; *(LAS u32x4*)(RawQ + (idx >> 4) * 128 + (idx & 15) * 8) = qr[it]; }
            vv[0] = vvn[0]; vv[1] = vvn[1];
#pragma unroll
            for (int et = 0; et < 8; ++et) { u32x2 w2; w2.x = cvt_pk_bf16(Srun[et][0], Srun[et][1]); w2.y = cvt_pk_bf16(Srun[et][2], Srun[et][3]); *(LAS u32x2*)(St + (16 * et + l15) * 136 + d0 + 4 * lq) = w2; }
            u32x2 gv[4]; f32x4 rgv[4];
#pragma unroll
            for (int et = 0; et < 4; ++et) { gv[et] = gvn[et]; rgv[et] = rgn[et]; }
#pragma unroll
            for (int it = 0; it < 2; ++it) { const int idx = tid + 512 * it, s = idx >> 4, e8 = idx & 15;
#pragma unroll
                for (int j = 0; j < 4; ++j) { const unsigned w = vv[it][j]; Vt[(e8 * 8 + 2 * j) * 72 + (s ^ ((e8 & 7) << 3))] = (bf16_t)(w & 0xffffu); Vt[(e8 * 8 + 2 * j + 1) * 72 + (s ^ ((e8 & 7) << 3))] = (bf16_t)(w >> 16); } }
            if (k8 + 1 < 8) H3_LOAD(unit + 1);
            __syncthreads();
            float lf0[8], lf1[8], q0[8], q1[8], bc0[8], bc1[8]; float run0 = 0.f, run1 = 0.f;
#pragma unroll
            for (int i = 0; i < 8; ++i) { const f32x2_t v2 = __builtin_convertvector(__builtin_bit_cast(h2v, *(const LAS unsigned*)(RawLF + (8 * part + i) * 128 + 2 * dp)), f32x2_t);
                const unsigned qw = *(const LAS unsigned*)(RawQ + (8 * part + i) * 128 + 2 * dp); q0[i] = bflo(qw); q1[i] = bfhi(qw);
                lf0[i] = v2.x; lf1[i] = v2.y; run0 += v2.x; run1 += v2.y; bc0[i] = run0; bc1[i] = run1; }
            *(LAS f32x2_t*)(PT + part * 128 + 2 * dp) = (f32x2_t){run0, run1};
            __syncthreads();
            float off0 = 0.f, off1 = 0.f;
#pragma unroll
            for (int p = 0; p < 7; ++p) if (p < part) { const f32x2_t pv = *(const LAS f32x2_t*)(PT + p * 128 + 2 * dp); off0 += pv.x; off1 += pv.y; }
            unsigned k0w[4], k1w[4];
#pragma unroll
            for (int i = 0; i < 8; i += 2) {
                float kk0[2], kk1[2];
#pragma unroll
                for (int u2 = 0; u2 < 2; ++u2) { const float ba = bc0[i + u2] + off0, bb_ = bc1[i + u2] + off1;
                    const float qa = q0[i + u2] * __expf(ba), qb_ = q1[i + u2] * __expf(bb_);
                    kk0[u2] = (1.0f - __expf(lf0[i + u2])) * __expf(-ba); kk1[u2] = (1.0f - __expf(lf1[i + u2])) * __expf(-bb_);
                    *(LAS unsigned*)(Qs + (8 * part + i + u2) * 136 + 2 * dp) = cvt_pk_bf16(qa, qb_);
                    *(LAS unsigned*)(Ks + (8 * part + i + u2) * 136 + 2 * dp) = cvt_pk_bf16(kk0[u2], kk1[u2]); }
                k0w[i >> 1] = cvt_pk_bf16(kk0[0], kk0[1]); k1w[i >> 1] = cvt_pk_bf16(kk1[0], kk1[1]); }
            *(LAS u32x4*)(Kt + (2 * dp) * 72 + 8 * part) = (u32x4){k0w[0], k0w[1], k0w[2], k0w[3]};
            *(LAS u32x4*)(Kt + (2 * dp + 1) * 72 + 8 * part) = (u32x4){k1w[0], k1w[1], k1w[2], k1w[3]};
            if (part == 7) *(LAS f32x2_t*)(DEC + 2 * dp) = (f32x2_t){__expf(bc0[7] + off0), __expf(bc1[7] + off1)};
            __syncthreads();
            {
                bf16x8 ka[2];
#pragma unroll
                for (int kk = 0; kk < 2; ++kk) ka[kk] = *(const LAS bf16x8*)(Kt + (d0 + l15) * 72 + 8 * lq + 32 * kk);
                const f32x4 dv = *(const LAS f32x4*)(DEC + d0 + 4 * lq);
#pragma unroll
                for (int et = 0; et < 8; ++et) { f32x4 acc = {0.f, 0.f, 0.f, 0.f};
#pragma unroll
                    for (int kk = 0; kk < 2; ++kk) { const bf16x8 bf = *(const LAS bf16x8*)(Vt + (16 * et + l15) * 72 + 8 * ((lq + 4 * kk) ^ ((2 * et + (l15 >> 3)) & 7))); acc = __builtin_amdgcn_mfma_f32_16x16x32_bf16(ka[kk], bf, acc, 0, 0, 0); }
                    Srun[et] = dv * (Srun[et] + acc); }
            }
            {
                const int tt = wave >> 1;
#pragma unroll
                for (int sti = 0; sti < 2; ++sti) { const int st = 2 * (wave & 1) + sti; f32x4 acc = {0.f, 0.f, 0.f, 0.f};
                    if (st <= tt) {
#pragma unroll
                        for (int kk = 0; kk < 4; ++kk) { const bf16x8 ak = *(const LAS bf16x8*)(Ks + (16 * st + l15) * 136 + 8 * lq + 32 * kk); const bf16x8 bq = *(const LAS bf16x8*)(Qs + (16 * tt + l15) * 136 + 8 * lq + 32 * kk);
                            acc = __builtin_amdgcn_mfma_f32_16x16x32_bf16(ak, bq, acc, 0, 0, 0); } }
                    const int t = 16 * tt + l15, s0 = 16 * st + 4 * lq;
#pragma unroll
                    for (int r = 0; r < 4; ++r) if (s0 + r > t) acc[r] = 0.f;
                    u32x2 w2; w2.x = cvt_pk_bf16(acc[0], acc[1]); w2.y = cvt_pk_bf16(acc[2], acc[3]);
                    *(LAS u32x2*)(As + t * 72 + s0) = w2; }
            }
            __syncthreads();
            {
                const int tt = wave & 3, eh = wave >> 2, t = 16 * tt + l15;
                bf16x8 bA[2], bQ[4];
#pragma unroll
                for (int kk = 0; kk < 2; ++kk) bA[kk] = *(const LAS bf16x8*)(As + t * 72 + 8 * lq + 32 * kk);
#pragma unroll
                for (int kk = 0; kk < 4; ++kk) bQ[kk] = *(const LAS bf16x8*)(Qs + t * 136 + 8 * lq + 32 * kk);
                f32x4 o[4]; float ss = 0.f;
#pragma unroll
                for (int et = 0; et < 4; ++et) { const int e0 = 16 * (4 * eh + et);
                    f32x4 acc = {0.f, 0.f, 0.f, 0.f};
#pragma unroll
                    for (int kk = 0; kk < 2; ++kk) { const bf16x8 av = *(const LAS bf16x8*)(Vt + (e0 + l15) * 72 + 8 * ((lq + 4 * kk) ^ (((e0 >> 3) + (l15 >> 3)) & 7))); acc = __builtin_amdgcn_mfma_f32_16x16x32_bf16(av, bA[kk], acc, 0, 0, 0); }
#pragma unroll
                    for (int kk = 0; kk < 4; ++kk) { const bf16x8 as = *(const LAS bf16x8*)(St + (e0 + l15) * 136 + 8 * lq + 32 * kk); acc = __builtin_amdgcn_mfma_f32_16x16x32_bf16(as, bQ[kk], acc, 0, 0, 0); }
                    o[et] = acc; ss += (acc[0] * acc[0] + acc[1] * acc[1]) + (acc[2] * acc[2] + acc[3] * acc[3]); }
                ss += __shfl_xor(ss, 16); ss += __shfl_xor(ss, 32);
                if (lq == 0) SS[t * 2 + eh] = ss;
                __syncthreads();
                const float rs = __builtin_amdgcn_rsqf((SS[t * 2] + SS[t * 2 + 1]) * (1.0f / HD) + EPS);
#pragma unroll
                for (int et = 0; et < 4; ++et) { const int e = 16 * (4 * eh + et) + 4 * lq; const f32x4 rg = rgv[et];
                    const float y0 = o[et][0] * rs * rg[0] * bflo(gv[et].x), y1 = o[et][1] * rs * rg[1] * bfhi(gv[et].x), y2 = o[et][2] * rs * rg[2] * bflo(gv[et].y), y3 = o[et][3] * rs * rg[3] * bfhi(gv[et].y);
                    u32x2 w2; w2.x = cvt_pk_bf16(y0, y1); w2.y = cvt_pk_bf16(y2, y3);
                    *(u32x2*)(yb + (r0 + t) * D + DC + h * HD + e) = w2; }
            }
            __syncthreads();
        }
        }
    }
    SEAM(4);

    if (IN(5)) { pg8::Gemm g{yb, WoutT, M, D, D}; pg8::StaticOrder S; S.init(M, D, G, (int)blockIdx.x);
        pg8::EpiOut E{xb, ssq2, rstd1};
        pg8::gemm_phase<pg8::EpiOut, pg8::StaticOrder, true, true>(lds, g, S, E);
        { pg8::Gemm g{pb, WpleT, M, D, PLE}; pg8::StaticOrder S; S.init(M, D, G, (int)blockIdx.x);
          pg8::EpiPle E{eb, ssqE};
          pg8::gemm_phase<pg8::EpiPle, pg8::StaticOrder, true, true>(lds, g, S, E); }
    }
    SEAM(5);
    if (IN(6)) { pg8::Gemm g{xb, WupT, M, FF, D}; pg8::StaticOrder S; S.init(M, FF, G, (int)blockIdx.x);
        pg8::EpiUp E{tb};
        pg8::gemm_phase<pg8::EpiUp, pg8::StaticOrder, true, true>(lds, g, S, E); }
    SEAM(6);
    if (IN(7)) { pg8::Gemm g{tb, WdownT, M, D, FF}; pg8::StaticOrder S; S.init(M, D, G, (int)blockIdx.x);
        pg8::EpiDown E{ssq2, xb};
        pg8::gemm_phase<pg8::EpiDown, pg8::StaticOrder, true, true>(lds, g, S, E); }
    SEAM(7);
    if (IN(8)) { pg8::Gemm g{xb, WgateT, M, D, D}; pg8::StaticOrder S; S.init(M, D, G, (int)blockIdx.x);
        pg8::EpiGateFinal E{outp, xb, eb, ssqE, args.in[15], ssq3, (unsigned*)(ws + WS_PCNT), args.in[17]};
        pg8::gemm_phase<pg8::EpiGateFinal, pg8::StaticOrder, true, true>(lds, g, S, E); }
    if (DBG_TS >= 0) { xcd_barrier(bar); if (blockIdx.x == 0 && tid == 0) { if (DBG_TS == 8) tsw[1] = __builtin_amdgcn_s_memrealtime() - tsw[0]; outp[0] = 4.0f * rintf((float)tsw[1] * 0.01f * 0.25f); } }
#undef IN
#undef SEAM
}

#ifndef DBG_STOP
#define DBG_STOP -1
#endif
#ifndef DBG_OFF
#define DBG_OFF (WS_LOGF + 32 * MiB)
#endif
__global__ void dbg_dump(const unsigned short* src, float* o, int n) { for (int i = blockIdx.x * blockDim.x + threadIdx.x; i < n; i += gridDim.x * blockDim.x) o[i] = (float)src[i]; }
extern "C" void kernel_launch(void* const* d_in, const int* in_sizes, int n_in, void* d_out, int out_size, void* d_ws, size_t ws_size, hipStream_t stream) {
    static int grid = 0;
    if (grid == 0) {
        if (n_in != 18 || in_sizes[0] != M * D || out_size != M * D || ws_size < WS_END) { fprintf(stderr, "kernel_launch: unexpected shapes (n_in %d, in0 %d, out %d, ws %zu)\n", n_in, n_in > 0 ? in_sizes[0] : -1, out_size, ws_size); grid = -1; return; }
        int dev = 0, cus = 0, per_cu = 0;
        hipGetDevice(&dev); hipDeviceGetAttribute(&cus, hipDeviceAttributeMultiprocessorCount, dev);
        if (hipFuncSetAttribute((const void*)mk_fwd, hipFuncAttributeMaxDynamicSharedMemorySize, LDS_BYTES) != hipSuccess) { fprintf(stderr, "kernel_launch: hipFuncSetAttribute failed\n"); grid = -1; return; }
        if (hipOccupancyMaxActiveBlocksPerMultiprocessor(&per_cu, (const void*)mk_fwd, NTHR, LDS_BYTES) != hipSuccess || per_cu < 1) { fprintf(stderr, "kernel_launch: occupancy query says %d\n", per_cu); per_cu = 1; }
        (void)hipGetLastError();
        grid = cus;
    }
    if (grid < 0) return;
    Args a{};
    for (int i = 0; i < 18; ++i) a.in[i] = (const float*)d_in[i];
    a.out = (float*)d_out; a.ws = (unsigned char*)d_ws;
#if MK_COOP
    if (hipMemsetAsync((char*)d_ws + WS_BAR, 0, 96 * 1024, stream) != hipSuccess) { fprintf(stderr, "kernel_launch: memset of the barrier words failed\n"); return; }
    a.ph_lo = 0; a.ph_hi = N_PHASES;
    void* kargs[] = {&a};
    hipError_t e = hipLaunchCooperativeKernel((const void*)mk_fwd, dim3(grid), dim3(NTHR), kargs, LDS_BYTES, stream);
    if (e != hipSuccess) fprintf(stderr, "cooperative launch failed: %s (grid %d)\n", hipGetErrorString(e), grid);
#else
    for (int p = 0; p < N_PHASES; ++p) { if (DBG_STOP >= 0 && p > DBG_STOP) break; a.ph_lo = p; a.ph_hi = p + 1; hipLaunchKernelGGL(mk_fwd, dim3(grid), dim3(NTHR), LDS_BYTES, stream, a); }
    if (DBG_STOP >= 0) hipLaunchKernelGGL(dbg_dump, dim3(2048), dim3(256), 0, stream, (const unsigned short*)((unsigned char*)d_ws + DBG_OFF), (float*)d_out, M * D);
#endif
}
```

```cpp
#include <hip/hip_runtime.h>
#include <hip/hip_cooperative_groups.h>
#include <cstdio>
#include <cstdint>
namespace cg = cooperative_groups;
namespace pg8 {
#define PG8_LAS __attribute__((address_space(3)))
typedef unsigned short bf16_t;
typedef short bf16x8 __attribute__((ext_vector_type(8)));
typedef float f32x4 __attribute__((ext_vector_type(4)));
typedef unsigned u32x4 __attribute__((ext_vector_type(4)));
constexpr int BM = 256, BK = 64, HALF = 128, HTB = HALF * BK * 2  , STAGE_BYTES = 8 * HTB, NXCD = 8, WGM = 8;

__host__ __device__ __forceinline__ int lds_byte(int r, int c) { const int st = (r >> 4) * 2 + (c >> 5), rr = r & 15, cc = c & 31, ob = rr * 64 + cc * 2; return st * 1024 + (ob ^ (((ob >> 9) & 1) << 5)); }
__host__ __device__ __forceinline__ void stage_rc(int b, int& R, int& C) { const int st = b / 1024, sb = b % 1024, swz = sb ^ (((sb >> 9) & 1) << 5); R = (st >> 1) * 16 + swz / 64; C = (st & 1) * 32 + (swz % 64) / 2; }
__host__ __device__ __forceinline__ int perm32(int rho) { const int n = rho >> 4, i = rho & 15; return 8 * (i >> 2) + 4 * n + (i & 3); }

struct Unit { int pm, pn; };
struct Gemm { const bf16_t* A; const bf16_t* Bt; int M, N, K; };

struct StaticOrder {
    int nM, nN, nwg, G, c;
    __host__ __device__ void init(int M, int N, int G_, int c_) { nM = M / BM; nN = N / BM; nwg = nM * nN; G = G_; c = c_; }
    __host__ __device__ bool next(int i, Unit& u) const {
        const long L = (long)i * G + c; if (L >= nwg) return false;
        int wgid = (int)L; { const int q = nwg / NXCD, r = nwg % NXCD, xcd = wgid % NXCD, off = wgid / NXCD; wgid = (xcd < r ? xcd * (q + 1) : r * (q + 1) + (xcd - r) * q) + off; }
        const int nig = WGM * nN, gid = wgid / nig, fm = gid * WGM, gsz = (nM - fm) < WGM ? (nM - fm) : WGM;
        u.pm = fm + ((wgid % nig) % gsz); u.pn = (wgid % nig) / gsz; return true;
    }
    __device__ __forceinline__ void a_ready(const Unit&) const {}
    __device__ __forceinline__ void done(const Unit&) const {}
};

typedef __bf16 bf16x2_t __attribute__((ext_vector_type(2)));
typedef float f32x2_t __attribute__((ext_vector_type(2)));
__device__ __forceinline__ unsigned cvt_pk_bf16(float lo, float hi) { const f32x2_t v = {lo, hi}; const bf16x2_t b = __builtin_convertvector(v, bf16x2_t); return __builtin_bit_cast(unsigned, b); }
typedef float f32x2 __attribute__((ext_vector_type(2)));
typedef unsigned u32x2 __attribute__((ext_vector_type(2)));
__device__ __forceinline__ float sigm(float x) { return __builtin_amdgcn_rcpf(1.0f + __expf(-x)); }
__device__ __forceinline__ unsigned cvt_pk_bf16_asm(float lo, float hi) { unsigned r; asm volatile("v_cvt_pk_bf16_f32 %0, %1, %2" : "=v"(r) : "v"(lo), "v"(hi)); return r; }
__device__ __forceinline__ u32x4 pack8(const f32x4& a, const f32x4& b) { u32x4 w; w.x = cvt_pk_bf16_asm(a[0], a[1]); w.y = cvt_pk_bf16_asm(a[2], a[3]); w.z = cvt_pk_bf16_asm(b[0], b[1]); w.w = cvt_pk_bf16_asm(b[2], b[3]); return w; }
__device__ __forceinline__ u32x4 pack8v(const f32x4& a, const f32x4& b) { u32x4 w; w.x = cvt_pk_bf16(a[0], a[1]); w.y = cvt_pk_bf16(a[2], a[3]); w.z = cvt_pk_bf16(b[0], b[1]); w.w = cvt_pk_bf16(b[2], b[3]); return w; }
__device__ __forceinline__ float bflo(unsigned w) { return __uint_as_float(w << 16); }
__device__ __forceinline__ float bfhi(unsigned w) { return __uint_as_float(w & 0xffff0000u); }
constexpr float EPS_ = 1e-6f;

struct EpiIn {
    static constexpr bool PERM = true, AFTER_DRAIN = false;
    const float* rstd1; const float* lbl; bf16_t* cglu; bf16_t* qb; bf16_t* gs; _Float16* logf; bf16_t* vb;
    __device__ __forceinline__ void operator()(const f32x4 (&acc)[2][2][4][2], const Unit& u, int wr, int wc, int fr, int fq) const {
        asm volatile("s_nop 15\n\ts_nop 15" ::: "memory");
        const int kind = u.pn >> 2, j = u.pn & 3;
        const int col = j * 128 + wc * 32 + 8 * fq;
        const int row0 = u.pm * BM + wr * 64 + fr;
        if (kind == 0) {
#pragma unroll
            for (int ai = 0; ai < 2; ++ai)
#pragma unroll
                for (int m = 0; m < 4; ++m) { const int row = row0 + ai * HALF + m * 16;
                    f32x4 a0 = acc[ai][0][m][0], a1 = acc[ai][0][m][1], b0 = acc[ai][1][m][0], b1 = acc[ai][1][m][1];
#pragma unroll
                    for (int e = 0; e < 4; ++e) { a0[e] *= sigm(b0[e]); a1[e] *= sigm(b1[e]); }
                    *(u32x4*)(cglu + (size_t)row * 512 + col) = pack8(a0, a1); }
        } else if (kind == 1) {
#pragma unroll
            for (int ai = 0; ai < 2; ++ai)
#pragma unroll
                for (int m = 0; m < 4; ++m) { const int row = row0 + ai * HALF + m * 16;
                    f32x4 a0 = acc[ai][0][m][0], a1 = acc[ai][0][m][1], b0 = acc[ai][1][m][0], b1 = acc[ai][1][m][1];
#pragma unroll
                    for (int e = 0; e < 4; ++e) { b0[e] *= sigm(b0[e]); b1[e] *= sigm(b1[e]); }
                    __builtin_nontemporal_store(pack8(a0, a1), (u32x4*)(qb + (size_t)row * 512 + col));
                    __builtin_nontemporal_store(pack8(b0, b1), (u32x4*)(gs + (size_t)row * 512 + col)); }
        } else {
            float lb[8];
#pragma unroll
            for (int e = 0; e < 8; ++e) lb[e] = __builtin_amdgcn_rcpf(1.0f + __expf(lbl[512 + col + e] - lbl[col + e]));
#pragma unroll
            for (int ai = 0; ai < 2; ++ai)
#pragma unroll
                for (int m = 0; m < 4; ++m) { const int row = row0 + ai * HALF + m * 16;
                    f32x4 a0 = acc[ai][0][m][0], a1 = acc[ai][0][m][1], b0 = acc[ai][1][m][0], b1 = acc[ai][1][m][1];
#pragma unroll
                    for (int e = 0; e < 4; ++e) { a0[e] = 0.69314718056f * __builtin_amdgcn_logf(lb[e] + (1.0f - lb[e]) * sigm(a0[e])); a1[e] = 0.69314718056f * __builtin_amdgcn_logf(lb[4 + e] + (1.0f - lb[4 + e]) * sigm(a1[e])); }
                    { typedef _Float16 h2_t __attribute__((ext_vector_type(2))); u32x4 w;
                      w.x = __builtin_bit_cast(unsigned, __builtin_convertvector((f32x2_t){a0[0], a0[1]}, h2_t)); w.y = __builtin_bit_cast(unsigned, __builtin_convertvector((f32x2_t){a0[2], a0[3]}, h2_t));
                      w.z = __builtin_bit_cast(unsigned, __builtin_convertvector((f32x2_t){a1[0], a1[1]}, h2_t)); w.w = __builtin_bit_cast(unsigned, __builtin_convertvector((f32x2_t){a1[2], a1[3]}, h2_t));
                      *(u32x4*)(logf + (size_t)row * 512 + col) = w; }
                    *(u32x4*)(vb + (size_t)row * 512 + col) = pack8(b0, b1); }
        }
    }
};
struct EpiPle {
    static constexpr bool PERM = true, AFTER_DRAIN = false;
    bf16_t* e; float* ssq;
    __device__ __forceinline__ void operator()(const f32x4 (&acc)[2][2][4][2], const Unit& u, int wr, int wc, int fr, int fq) const {
        asm volatile("s_nop 15\n\ts_nop 15" ::: "memory");
        const int row0 = u.pm * BM + wr * 64 + fr, col0 = u.pn * BM + wc * 32 + 8 * fq;
#pragma unroll
        for (int ai = 0; ai < 2; ++ai)
#pragma unroll
            for (int m = 0; m < 4; ++m) { const int row = row0 + ai * HALF + m * 16; float ss = 0.f;
#pragma unroll
                for (int bj = 0; bj < 2; ++bj) { const f32x4 a0 = acc[ai][bj][m][0], a1 = acc[ai][bj][m][1];
                    __builtin_nontemporal_store(pack8(a0, a1), (u32x4*)(e + (size_t)row * 1024 + col0 + bj * HALF));
                    ss += (a0[0] * a0[0] + a0[1] * a0[1]) + (a0[2] * a0[2] + a0[3] * a0[3]) + (a1[0] * a1[0] + a1[1] * a1[1]) + (a1[2] * a1[2] + a1[3] * a1[3]); }
                ss += __shfl_xor(ss, 16); ss += __shfl_xor(ss, 32);
                if (fq == 0) __hip_atomic_fetch_add(ssq + row, ss, __ATOMIC_RELAXED, __HIP_MEMORY_SCOPE_AGENT); }
    }
};
struct EpiOut {
    static constexpr bool PERM = true, AFTER_DRAIN = false;
    bf16_t* hb; float* ssq; const float* inv1;
    __device__ __forceinline__ void operator()(const f32x4 (&acc)[2][2][4][2], const Unit& u, int wr, int wc, int fr, int fq) const {
        asm volatile("s_nop 15\n\ts_nop 15" ::: "memory");
        const int row0 = u.pm * BM + wr * 64 + fr, col0 = u.pn * BM + wc * 32 + 8 * fq;
        float iv[8];
#pragma unroll
        for (int g = 0; g < 8; ++g) iv[g] = inv1[row0 + (g >> 2) * HALF + (g & 3) * 16];
        u32x4 hq[8][2];
#define EPI_H(g_) do { _Pragma("unroll") for (int bj = 0; bj < 2; ++bj) hq[g_][bj] = *(const u32x4*)(hb + (size_t)(row0 + ((g_) >> 2) * HALF + ((g_) & 3) * 16) * 1024 + col0 + bj * HALF); } while (0)
        EPI_H(0); EPI_H(1); EPI_H(2); EPI_H(3);
        asm volatile("" ::: "memory");
#pragma unroll
        for (int g = 0; g < 8; ++g) { const int ai = g >> 2, m = g & 3; const int row = row0 + ai * HALF + m * 16; float ss = 0.f;
            if (g + 4 < 8) EPI_H(g + 4);
#pragma unroll
            for (int bj = 0; bj < 2; ++bj) { const size_t off = (size_t)row * 1024 + col0 + bj * HALF;
                const u32x4 hv = hq[g][bj];
                const f32x4 h0 = {bflo(hv.x), bfhi(hv.x), bflo(hv.y), bfhi(hv.y)}, h1 = {bflo(hv.z), bfhi(hv.z), bflo(hv.w), bfhi(hv.w)};
                const f32x4 a0 = h0 * iv[g] + acc[ai][bj][m][0], a1 = h1 * iv[g] + acc[ai][bj][m][1];
                *(u32x4*)(hb + off) = pack8(a0, a1);
                ss += (a0[0] * a0[0] + a0[1] * a0[1]) + (a0[2] * a0[2] + a0[3] * a0[3]) + (a1[0] * a1[0] + a1[1] * a1[1]) + (a1[2] * a1[2] + a1[3] * a1[3]); }
            ss += __shfl_xor(ss, 16); ss += __shfl_xor(ss, 32);
            if (fq == 0) __hip_atomic_fetch_add(ssq + row, ss, __ATOMIC_RELAXED, __HIP_MEMORY_SCOPE_AGENT);
            asm volatile("" ::: "memory"); }
#undef EPI_H
    }
};
struct EpiUp {
    static constexpr bool PERM = true, AFTER_DRAIN = false;
    bf16_t* t;
    __device__ __forceinline__ void operator()(const f32x4 (&acc)[2][2][4][2], const Unit& u, int wr, int wc, int fr, int fq) const {
        asm volatile("s_nop 15\n\ts_nop 15" ::: "memory");
        const int row0 = u.pm * BM + wr * 64 + fr, col0 = u.pn * BM + wc * 32 + 8 * fq;
#pragma unroll
        for (int ai = 0; ai < 2; ++ai)
#pragma unroll
            for (int m = 0; m < 4; ++m) { const int row = row0 + ai * HALF + m * 16;
#pragma unroll
                for (int bj = 0; bj < 2; ++bj) { f32x4 a0 = acc[ai][bj][m][0], a1 = acc[ai][bj][m][1];
#pragma unroll
                    for (int e = 0; e < 4; ++e) { const float p = fmaxf(a0[e], 0.f), q = fmaxf(a1[e], 0.f); a0[e] = p * p; a1[e] = q * q; }
                    *(u32x4*)(t + (size_t)row * 4096 + col0 + bj * HALF) = pack8(a0, a1); } }
    }
};
struct EpiDown {
    static constexpr bool PERM = true, AFTER_DRAIN = false;
    const float* ssq2; bf16_t* hb;
    __device__ __forceinline__ void operator()(const f32x4 (&acc)[2][2][4][2], const Unit& u, int wr, int wc, int fr, int fq) const {
        asm volatile("s_nop 15\n\ts_nop 15" ::: "memory");
        const int row0 = u.pm * BM + wr * 64 + fr, col0 = u.pn * BM + wc * 32 + 8 * fq;
        u32x4 hq[8][2]; float sq[8];
#pragma unroll
        for (int g = 0; g < 8; ++g) sq[g] = ssq2[row0 + (g >> 2) * HALF + (g & 3) * 16];
#define EPI_H(g_) do { _Pragma("unroll") for (int bj = 0; bj < 2; ++bj) hq[g_][bj] = *(const u32x4*)(hb + (size_t)(row0 + ((g_) >> 2) * HALF + ((g_) & 3) * 16) * 1024 + col0 + bj * HALF); } while (0)
        EPI_H(0); EPI_H(1); EPI_H(2); EPI_H(3);
        asm volatile("" ::: "memory");
#pragma unroll
        for (int g = 0; g < 8; ++g) { const int ai = g >> 2, m = g & 3; const int row = row0 + ai * HALF + m * 16; const float r2 = __builtin_amdgcn_rcpf(sq[g] * (1.0f / 1024.0f) + EPS_);
            if (g + 4 < 8) EPI_H(g + 4);
#pragma unroll
            for (int bj = 0; bj < 2; ++bj) { const size_t off = (size_t)row * 1024 + col0 + bj * HALF;
                const u32x4 hv = hq[g][bj];
                const f32x4 h0 = {bflo(hv.x), bfhi(hv.x), bflo(hv.y), bfhi(hv.y)}, h1 = {bflo(hv.z), bfhi(hv.z), bflo(hv.w), bfhi(hv.w)};
                const f32x4 a0 = h0 + acc[ai][bj][m][0] * r2, a1 = h1 + acc[ai][bj][m][1] * r2;
                *(u32x4*)(hb + off) = pack8(a0, a1); }
            asm volatile("" ::: "memory"); }
#undef EPI_H
    }
};
struct EpiGateFinal {
    static constexpr bool PERM = true, AFTER_DRAIN = false;
    float* out; const bf16_t* hb; const bf16_t* e; const float* ssqE; const float* gple; float* ssq3; unsigned* cnt; const float* gfin;
    __device__ __forceinline__ void operator()(f32x4 (&acc)[2][2][4][2], const Unit& u, int wr, int wc, int fr, int fq) const {
        asm volatile("s_nop 15\n\ts_nop 15" ::: "memory");
        const int row0 = u.pm * BM + wr * 64 + fr, col0 = u.pn * BM + wc * 32 + 8 * fq;
        {
        u32x4 hq[8][2], eq[8][2]; float sq[8];
#define EGF_E(g_) do { _Pragma("unroll") for (int bj = 0; bj < 2; ++bj) eq[g_][bj] = __builtin_nontemporal_load((const u32x4*)(e + (size_t)(row0 + ((g_) >> 2) * HALF + ((g_) & 3) * 16) * 1024 + col0 + bj * HALF)); } while (0)
#pragma unroll
        for (int g = 0; g < 8; ++g) sq[g] = ssqE[row0 + (g >> 2) * HALF + (g & 3) * 16];
#define EGF_H(g_) do { _Pragma("unroll") for (int bj = 0; bj < 2; ++bj) hq[g_][bj] = *(const u32x4*)(hb + (size_t)(row0 + ((g_) >> 2) * HALF + ((g_) & 3) * 16) * 1024 + col0 + bj * HALF); } while (0)
        EGF_H(0); EGF_E(0); EGF_H(1); EGF_E(1);
        f32x4 gp[2][2];
#pragma unroll
        for (int bj = 0; bj < 2; ++bj) { gp[bj][0] = *(const f32x4*)(gple + col0 + bj * HALF); gp[bj][1] = *(const f32x4*)(gple + col0 + bj * HALF + 4); }
        asm volatile("" ::: "memory");
#pragma unroll
        for (int g = 0; g < 8; ++g) { const int ai = g >> 2, m = g & 3; const int row = row0 + ai * HALF + m * 16; const float rE = __builtin_amdgcn_rsqf(sq[g] * (1.0f / 1024.0f) + EPS_); float ss = 0.f;
            if (g + 2 < 8) { EGF_H(g + 2); EGF_E(g + 2); }
#pragma unroll
            for (int bj = 0; bj < 2; ++bj) {
                const u32x4 ev = eq[g][bj];
                f32x4 e0 = {bflo(ev.x), bfhi(ev.x), bflo(ev.y), bfhi(ev.y)}, e1 = {bflo(ev.z), bfhi(ev.z), bflo(ev.w), bfhi(ev.w)};
                f32x4 s0 = acc[ai][bj][m][0], s1 = acc[ai][bj][m][1];
#pragma unroll
                for (int k = 0; k < 4; ++k) { s0[k] = sigm(s0[k]); s1[k] = sigm(s1[k]); }
                const u32x4 hv = hq[g][bj];
                const f32x4 h0 = {bflo(hv.x), bfhi(hv.x), bflo(hv.y), bfhi(hv.y)}, h1 = {bflo(hv.z), bfhi(hv.z), bflo(hv.w), bfhi(hv.w)};
                const f32x4 a0 = h0 + e0 * rE * gp[bj][0] * s0, a1 = h1 + e1 * rE * gp[bj][1] * s1;
                acc[ai][bj][m][0] = a0; acc[ai][bj][m][1] = a1;
                ss += (a0[0] * a0[0] + a0[1] * a0[1]) + (a0[2] * a0[2] + a0[3] * a0[3]) + (a1[0] * a1[0] + a1[1] * a1[1]) + (a1[2] * a1[2] + a1[3] * a1[3]); }
            ss += __shfl_xor(ss, 16); ss += __shfl_xor(ss, 32);
            if (fq == 0) __hip_atomic_fetch_add(ssq3 + row, ss, __ATOMIC_RELAXED, __HIP_MEMORY_SCOPE_AGENT);
            asm volatile("" ::: "memory"); }
#undef EGF_E
#undef EGF_H
        }
        f32x4 gf[2][2];
#pragma unroll
        for (int bj = 0; bj < 2; ++bj) { gf[bj][0] = *(const f32x4*)(gfin + col0 + bj * HALF); gf[bj][1] = *(const f32x4*)(gfin + col0 + bj * HALF + 4); }
        asm volatile("s_waitcnt vmcnt(0)" ::: "memory");
        unsigned* pc = cnt + 64 * u.pm;
        if ((threadIdx.x & 63) == 0) __hip_atomic_fetch_add(pc, 1u, __ATOMIC_RELAXED, __HIP_MEMORY_SCOPE_AGENT);
        { unsigned sp = 0;
          while ((unsigned)__builtin_amdgcn_readfirstlane(__hip_atomic_load(pc, __ATOMIC_RELAXED, __HIP_MEMORY_SCOPE_AGENT)) < 32u) { __builtin_amdgcn_s_sleep(2); if (++sp > (1u << 22)) break; } }
        __builtin_amdgcn_fence(__ATOMIC_ACQUIRE, "agent");
        float s3[8];
#pragma unroll
        for (int g = 0; g < 8; ++g) s3[g] = __hip_atomic_load(ssq3 + row0 + (g >> 2) * HALF + (g & 3) * 16, __ATOMIC_RELAXED, __HIP_MEMORY_SCOPE_AGENT);
#pragma unroll
        for (int ai = 0; ai < 2; ++ai)
#pragma unroll
            for (int m = 0; m < 4; ++m) { const int row = row0 + ai * HALF + m * 16;
                const float rs = __builtin_amdgcn_rsqf(s3[ai * 4 + m] * (1.0f / 1024.0f) + EPS_);
#pragma unroll
                for (int bj = 0; bj < 2; ++bj) { const size_t off = (size_t)row * 1024 + col0 + bj * HALF;
                    *(f32x4*)(out + off) = acc[ai][bj][m][0] * rs * gf[bj][0]; *(f32x4*)(out + off + 4) = acc[ai][bj][m][1] * rs * gf[bj][1]; }
                asm volatile("" ::: "memory"); }
    }
};

template <class Epi, class Sched, bool ALIGN_EPI = false, bool SP2 = false>
__device__ __forceinline__ void gemm_phase(PG8_LAS unsigned char* lds, const Gemm g, const Sched& S, const Epi& E) {
    const int tid = threadIdx.x, wid = __builtin_amdgcn_readfirstlane(tid >> 6), lane = tid & 63, wr = wid >> 2, wc = wid & 3, fr = lane & 15, fq = lane >> 4;
    const int K = g.K, nt = K / BK;
    unsigned voffA[2], voffB[2];
#pragma unroll
    for (int i = 0; i < 2; ++i) { int R, C; stage_rc(tid * 16 + i * 8192, R, C); const int Rb = Epi::PERM ? ((R & ~31) + perm32(R & 31)) : R;
        voffA[i] = (unsigned)(R * K + C) * 2u; voffB[i] = (unsigned)(Rb * K + C) * 2u; }
    const size_t kstep = (size_t)(BK * 2);
    const size_t hstep = (size_t)HALF * K * 2;
    const size_t tstep = 2 * hstep;
    const unsigned ldsw = (unsigned)wid * 1024u;
    const int aoff = lds_byte(wr * 64 + fr, fq * 8), boff = lds_byte(wc * 32 + fr, fq * 8);
#define PG8_SA(b, h) (((b) * 2 + (h)) * HTB)
#define PG8_SB(b, h) ((4 + (b) * 2 + (h)) * HTB)
#define PG8_STAGE(bufoff, gbase, voff) do { _Pragma("unroll") for (int _i = 0; _i < 2; ++_i) \
        __builtin_amdgcn_global_load_lds((const unsigned*)((const char*)(gbase) + (voff)[_i]), (PG8_LAS unsigned*)(lds + (bufoff) + ldsw + _i * 8192), 16, 0, 0); } while (0)
#define PG8_LDA(dst, b, h) do { _Pragma("unroll") for (int m = 0; m < 4; ++m) _Pragma("unroll") for (int k = 0; k < 2; ++k) dst[m][k] = *(const PG8_LAS bf16x8*)(lds + PG8_SA(b, h) + aoff + m * 2048 + k * 1024); } while (0)
#define PG8_LDB(dst, b, h) do { _Pragma("unroll") for (int n = 0; n < 2; ++n) _Pragma("unroll") for (int k = 0; k < 2; ++k) dst[n][k] = *(const PG8_LAS bf16x8*)(lds + PG8_SB(b, h) + boff + n * 2048 + k * 1024); } while (0)
#define PG8_MMA(ai, bj, At, Bt) do { __builtin_amdgcn_s_setprio(1); _Pragma("unroll") for (int m = 0; m < 4; ++m) _Pragma("unroll") for (int n = 0; n < 2; ++n) _Pragma("unroll") for (int k = 0; k < 2; ++k) \
        acc[ai][bj][m][n] = __builtin_amdgcn_mfma_f32_16x16x32_bf16(Bt[n][k], At[m][k], acc[ai][bj][m][n], 0, 0, 0); __builtin_amdgcn_s_setprio(0); } while (0)
#define PG8_WAIT_V(n) asm volatile("s_waitcnt vmcnt(" #n ")" ::: "memory")
#define PG8_WAIT_L(n) asm volatile("s_waitcnt lgkmcnt(" #n ")" ::: "memory")
#define PG8_BAR __builtin_amdgcn_s_barrier()
#define PG8_SCHED __builtin_amdgcn_sched_barrier(0)
    Unit cur, nxt; int ui = 0;
    if (!S.next(0, cur)) return;
    f32x4 acc[2][2][4][2];
#pragma unroll
    for (int a = 0; a < 2; ++a)
#pragma unroll
        for (int b = 0; b < 2; ++b)
#pragma unroll
            for (int m = 0; m < 4; ++m)
#pragma unroll
                for (int n = 0; n < 2; ++n) acc[a][b][m][n] = (f32x4){0.f, 0.f, 0.f, 0.f};
    bf16x8 At[4][2], B0[2][2], B1[2][2];
    const char* cA = (const char*)g.A + (size_t)cur.pm * tstep; const char* cB = (const char*)g.Bt + (size_t)cur.pn * tstep;
    S.a_ready(cur);
    if constexpr (SP2) {
        PG8_STAGE(PG8_SB(0, 0), cB, voffB); PG8_STAGE(PG8_SB(0, 1), cB + hstep, voffB); PG8_STAGE(PG8_SA(0, 0), cA, voffA); PG8_STAGE(PG8_SA(0, 1), cA + hstep, voffA);
        if (wr == 1) PG8_BAR;
        PG8_WAIT_V(2); PG8_BAR;
        PG8_STAGE(PG8_SB(1, 0), cB + kstep, voffB); PG8_STAGE(PG8_SA(1, 0), cA + kstep, voffA); PG8_STAGE(PG8_SB(1, 1), cB + hstep + kstep, voffB);
        PG8_WAIT_V(6); PG8_BAR;
    } else {
        PG8_STAGE(PG8_SB(0, 0), cB, voffB); PG8_STAGE(PG8_SA(0, 0), cA, voffA); PG8_STAGE(PG8_SB(0, 1), cB + hstep, voffB); PG8_STAGE(PG8_SA(0, 1), cA + hstep, voffA);
        if (wr == 1) PG8_BAR;
        PG8_WAIT_V(4); PG8_BAR;
        PG8_STAGE(PG8_SB(1, 0), cB + kstep, voffB); PG8_STAGE(PG8_SA(1, 0), cA + kstep, voffA); PG8_STAGE(PG8_SB(1, 1), cB + hstep + kstep, voffB);
        PG8_WAIT_V(6); PG8_BAR;
    }
    for (;;) {
        const bool has_next = S.next(ui + 1, nxt);
        const char* nA = has_next ? (const char*)g.A + (size_t)nxt.pm * tstep : cA; const char* nB = has_next ? (const char*)g.Bt + (size_t)nxt.pn * tstep : cB;
        for (int t = 0; t < nt; t += 2) {
            const bool last = (t == nt - 2);
            const char* a1 = cA + (size_t)(t + 1) * kstep;
            const char* a2 = last ? nA : cA + (size_t)(t + 2) * kstep; const char* b2 = last ? nB : cB + (size_t)(t + 2) * kstep;
            const char* a3 = a2 + kstep; const char* b3 = b2 + kstep;
            if (last && has_next) S.a_ready(nxt);
            if constexpr (SP2) {
            PG8_LDB(B0, 0, 0); PG8_LDB(B1, 0, 1); PG8_SCHED; PG8_LDA(At, 0, 0); PG8_STAGE(PG8_SA(1, 1), a1 + hstep, voffA);
            PG8_WAIT_V(8); PG8_WAIT_L(0); PG8_BAR; PG8_MMA(0, 0, At, B0); PG8_MMA(0, 1, At, B1); PG8_BAR; PG8_SCHED;
            PG8_LDA(At, 0, 1); PG8_STAGE(PG8_SB(0, 0), b2, voffB); PG8_STAGE(PG8_SB(0, 1), b2 + hstep, voffB); PG8_STAGE(PG8_SA(0, 0), a2, voffA);
            PG8_WAIT_V(8); PG8_WAIT_L(0); PG8_BAR; PG8_MMA(1, 0, At, B0); PG8_MMA(1, 1, At, B1); PG8_BAR; PG8_SCHED;
            PG8_LDB(B0, 1, 0); PG8_LDB(B1, 1, 1); PG8_SCHED; PG8_LDA(At, 1, 0); PG8_STAGE(PG8_SA(0, 1), a2 + hstep, voffA);
            PG8_WAIT_V(8); PG8_WAIT_L(0); PG8_BAR; PG8_MMA(0, 0, At, B0); PG8_MMA(0, 1, At, B1); PG8_BAR; PG8_SCHED;
            PG8_LDA(At, 1, 1); PG8_STAGE(PG8_SB(1, 0), b3, voffB); PG8_STAGE(PG8_SB(1, 1), b3 + hstep, voffB); PG8_STAGE(PG8_SA(1, 0), a3, voffA);
            PG8_WAIT_V(8); PG8_WAIT_L(0); PG8_BAR; PG8_MMA(1, 0, At, B0); PG8_MMA(1, 1, At, B1); PG8_BAR; PG8_SCHED;
            } else {
            PG8_LDB(B0, 0, 0); PG8_SCHED; PG8_LDA(At, 0, 0); PG8_STAGE(PG8_SA(1, 1), a1 + hstep, voffA);
            PG8_WAIT_L(8); PG8_BAR; PG8_WAIT_L(0); PG8_MMA(0, 0, At, B0); PG8_BAR; PG8_SCHED;
            PG8_LDB(B1, 0, 1); PG8_STAGE(PG8_SB(0, 0), b2, voffB);
            PG8_BAR; PG8_WAIT_L(0); PG8_MMA(0, 1, At, B1); PG8_BAR;
            PG8_LDA(At, 0, 1); PG8_STAGE(PG8_SA(0, 0), a2, voffA);
            PG8_BAR; PG8_WAIT_L(0); PG8_MMA(1, 0, At, B0); PG8_BAR; PG8_SCHED;
            PG8_STAGE(PG8_SB(0, 1), b2 + hstep, voffB);
            PG8_WAIT_V(6); PG8_BAR; PG8_MMA(1, 1, At, B1); PG8_BAR;
            PG8_LDB(B0, 1, 0); PG8_SCHED; PG8_LDA(At, 1, 0); PG8_STAGE(PG8_SA(0, 1), a2 + hstep, voffA);
            PG8_WAIT_L(8); PG8_BAR; PG8_WAIT_L(0); PG8_MMA(0, 0, At, B0); PG8_BAR; PG8_SCHED;
            PG8_LDB(B1, 1, 1); PG8_STAGE(PG8_SB(1, 0), b3, voffB);
            PG8_BAR; PG8_WAIT_L(0); PG8_MMA(0, 1, At, B1); PG8_BAR;
            PG8_LDA(At, 1, 1); PG8_STAGE(PG8_SA(1, 0), a3, voffA);
            PG8_BAR; PG8_WAIT_L(0); PG8_MMA(1, 0, At, B0); PG8_BAR; PG8_SCHED;
            PG8_STAGE(PG8_SB(1, 1), b3 + hstep, voffB);
            PG8_WAIT_V(6); PG8_BAR; PG8_MMA(1, 1, At, B1); PG8_BAR;
            }
        }
        if constexpr (ALIGN_EPI) { if (wr == 0) PG8_BAR; }
        if constexpr (!Epi::AFTER_DRAIN) { E(acc, cur, wr, wc, fr, fq); S.done(cur); }
        if (!has_next) break;
#pragma unroll
        for (int a = 0; a < 2; ++a)
#pragma unroll
            for (int b = 0; b < 2; ++b)
#pragma unroll
                for (int m = 0; m < 4; ++m)
#pragma unroll
                    for (int n = 0; n < 2; ++n) acc[a][b][m][n] = (f32x4){0.f, 0.f, 0.f, 0.f};
        cur = nxt; cA = nA; cB = nB; ++ui;
        if constexpr (ALIGN_EPI) { if (wr == 1) PG8_BAR; }
    }
    PG8_WAIT_V(0);
    if constexpr (!ALIGN_EPI) { if (wr == 0) PG8_BAR; }
    PG8_BAR;
    if constexpr (Epi::AFTER_DRAIN) { E.fused(acc, cur, wr, wc, fr, fq, lds, wid, lane); S.done(cur); }
#undef PG8_SA
#undef PG8_SB
#undef PG8_STAGE
#undef PG8_LDA
#undef PG8_LDB
#undef PG8_MMA
#undef PG8_WAIT_V
#undef PG8_WAIT_L
#undef PG8_BAR
#undef PG8_SCHED
}
}

#define LAS __attribute__((address_space(3)))
typedef unsigned short bf16_t;
typedef short bf16x8 __attribute__((ext_vector_type(8)));
typedef float f32x4 __attribute__((ext_vector_type(4)));
typedef unsigned u32x4 __attribute__((ext_vector_type(4)));
typedef unsigned u32x2 __attribute__((ext_vector_type(2)));
using pg8::cvt_pk_bf16; using pg8::bflo; using pg8::bfhi; using pg8::sigm; using pg8::f32x2_t;

#ifndef MK_COOP
#define MK_COOP 1
#endif
constexpr int NWAVES = 8, NTHR = 512;
constexpr int BATCH = 8, SEQ = 4096, D = 1024, M = BATCH * SEQ, DIN = 3072, FF = 4096, PLE = 256, DC = 512, DR = 512, NH = 4, HD = 128, CH = 64, NCHUNK = SEQ / CH;
constexpr int NUNIT = BATCH * NH * NCHUNK;
constexpr float EPS = 1e-6f;
constexpr int N_PHASES = 9;
constexpr size_t MiB = 1u << 20;
constexpr size_t WS_PCNT = 576 * 1024;
constexpr size_t WS_BAR = 512 * 1024;
constexpr size_t WS_RSTD1 = 0, WS_SSQ2 = 128 * 1024, WS_SSQE = 256 * 1024, WS_SSQ3 = 384 * 1024, WS_DEC = 1 * MiB;
constexpr size_t WS_WIN = 2 * MiB, WS_WOUT = 8 * MiB, WS_WUP = 10 * MiB, WS_WDOWN = 18 * MiB, WS_WPLE = 26 * MiB, WS_WGATE = 27 * MiB;
constexpr size_t WS_XB = 32 * MiB;
constexpr size_t WS_PB = 96 * MiB;
constexpr size_t WS_CGLU = 112 * MiB, WS_QB = 144 * MiB, WS_GS = 176 * MiB, WS_LOGF = 208 * MiB, WS_VB = 272 * MiB, WS_UT = 304 * MiB;
constexpr size_t WS_T = 112 * MiB;
constexpr size_t WS_Y = 368 * MiB;
constexpr size_t WS_E = 432 * MiB;
constexpr size_t WS_ASEG = 496 * MiB, WS_ESEG = 504 * MiB;
constexpr size_t WS_DSEG = 29 * MiB;
constexpr size_t WS_END = 512 * MiB;
constexpr int LDS_BYTES = 147456;

__device__ __forceinline__ float wave_sum(float v) {
#pragma unroll
    for (int o = 1; o < 64; o <<= 1) v += __shfl_xor(v, o);
    return v;
}
#define LDS_WAIT() asm volatile("s_waitcnt lgkmcnt(0)" ::: "memory")

__device__ __forceinline__ void transpose_item(const float* W, int K, int N, bf16_t* WT, int mode, const float* gain, LAS float* scr, int item, int lane) {
    const int nblk = N / 32, kb = item / nblk, nb = item % nblk, k0 = 64 * kb, n0 = 32 * nb;
#pragma unroll 8
    for (int i = 0; i < 32; ++i) { const int kk = 2 * i + (lane >> 5); float w = __builtin_nontemporal_load(W + (size_t)(k0 + kk) * N + n0 + (lane & 31)); if (gain) w *= gain[k0 + kk]; scr[kk * 33 + (lane & 31)] = w; }
    LDS_WAIT();
    int drow0 = n0;
    if (mode == 1) { const int region = n0 >> 9, within = n0 & 511, j = within >> 7, c0 = within & 127;
        int tile, bj;
        switch (region) { case 0: tile = j; bj = 0; break; case 1: tile = j; bj = 1; break; case 2: tile = 4 + j; bj = 0; break;
                          case 3: tile = 8 + j; bj = 0; break; case 4: tile = 8 + j; bj = 1; break; default: tile = 4 + j; bj = 1; break; }
        drow0 = tile * 256 + bj * 128 + c0; }
    const int c = lane & 7;
#pragma unroll
    for (int j = 0; j < 4; ++j) { const int n = (lane >> 3) + 8 * j; const LAS float* s = scr + (8 * c) * 33 + n;
        u32x4 o; o.x = cvt_pk_bf16(s[0 * 33], s[1 * 33]); o.y = cvt_pk_bf16(s[2 * 33], s[3 * 33]); o.z = cvt_pk_bf16(s[4 * 33], s[5 * 33]); o.w = cvt_pk_bf16(s[6 * 33], s[7 * 33]);
        *(u32x4*)(WT + (size_t)(drow0 + n) * K + k0 + 8 * c) = o; }
    LDS_WAIT();
}

typedef __attribute__((address_space(1))) unsigned gu32;
#define XB_TMO      128
#define XB_XCNT(j)  (256  + 64 * (j))
#define XB_XSUB(j)  (1280 + 64 * (j))
#define XB_XGEN(j)  (2304 + 64 * (j))
#define XB_TOP      3328
#define XB_TOPGEN   3392
#define XCD_BAR_WORDS 3456
#define XB_SPIN_CAP (1u << 18)

__device__ __forceinline__ unsigned xb_ld(unsigned* p)              { return __hip_atomic_load(p, __ATOMIC_RELAXED, __HIP_MEMORY_SCOPE_AGENT); }
__device__ __forceinline__ unsigned xb_add(unsigned* p, unsigned v) { return __hip_atomic_fetch_add(p, v, __ATOMIC_RELAXED, __HIP_MEMORY_SCOPE_AGENT); }
__device__ __forceinline__ unsigned xb_xcc_id() { return (unsigned)__builtin_amdgcn_s_getreg((3 << 11) | 20) & 0xFu; }
#define XB_SPIN(cond, bar) do { unsigned _sp = 0; while (cond) { __builtin_amdgcn_s_sleep(1); \
    if ((++_sp & 255u) == 0u) { if (xb_ld(&(bar)[XB_TMO])) break; if (_sp > XB_SPIN_CAP) { atomicAdd(&(bar)[XB_TMO], 1u); break; } } } } while (0)

struct XcdBarrier {
    unsigned* bar; unsigned x;
    volatile LAS unsigned* st;
};

__device__ __forceinline__ XcdBarrier xcd_barrier_post(unsigned* bar, volatile LAS unsigned* st) {
    XcdBarrier b; b.bar = bar; b.x = xb_xcc_id(); b.st = st;
    if (threadIdx.x == 0) (void)xb_add(&bar[XB_XCNT(b.x)], 1u);
    return b;
}
__device__ __forceinline__ void xcd_barrier_complete(unsigned* bar, unsigned x, unsigned& nloc, unsigned& nx) {
    const unsigned G = gridDim.x * gridDim.y * gridDim.z;
    unsigned sum, cnt, mine, sp = 0u;
    for (;;) {
        sum = 0u; cnt = 0u; mine = 0u;
#pragma unroll
        for (unsigned j = 0; j < 16; ++j) { const unsigned c = xb_ld(&bar[XB_XCNT(j)]); sum += c; cnt += (c > 0u) ? 1u : 0u; mine = (j == x) ? c : mine; }
        if (sum == G) break;
        __builtin_amdgcn_s_sleep(1);
        if ((++sp & 255u) == 0u) { if (xb_ld(&bar[XB_TMO])) break; if (sp > XB_SPIN_CAP) { atomicAdd(&bar[XB_TMO], 1u); break; } }
    }
    nloc = mine > 0u ? mine : 1u; nx = cnt > 0u ? cnt : 1u;
}

__device__ __forceinline__ void xcd_barrier(const XcdBarrier& b) {
    asm volatile("s_waitcnt vmcnt(0)" ::: "memory");
    __syncthreads();
    if (threadIdx.x == 0) {
        unsigned* bar = b.bar;
        __builtin_amdgcn_s_waitcnt(0);
        unsigned nloc = b.st[0], nx = b.st[1];
        if (nloc == 0u) { xcd_barrier_complete(bar, b.x, nloc, nx); b.st[0] = nloc; b.st[1] = nx; }
        const unsigned old = xb_add(&bar[XB_XSUB(b.x)], 1u);
        const unsigned gen = old / nloc;
        if (old + 1u == (gen + 1u) * nloc) {
            __builtin_amdgcn_fence(__ATOMIC_RELEASE, "agent");
            asm volatile("s_waitcnt vmcnt(0)" ::: "memory");
            const unsigned og = xb_add(&bar[XB_TOP], 1u);
            const unsigned tg = og / nx;
            if (og + 1u == (tg + 1u) * nx) xb_add(&bar[XB_TOPGEN], 1u);
            else XB_SPIN(xb_ld(&bar[XB_TOPGEN]) == tg, bar);
            __builtin_amdgcn_fence(__ATOMIC_ACQUIRE, "agent");
            xb_add(&bar[XB_XGEN(b.x)], 1u);
            asm volatile("s_waitcnt vmcnt(0)" ::: "memory");
        } else {
            XB_SPIN(xb_ld(&bar[XB_XGEN(b.x)]) == gen, bar);
            __builtin_amdgcn_fence(__ATOMIC_ACQUIRE, "agent");
            asm volatile("s_waitcnt vmcnt(0)" ::: "memory");
        }
    }
    __syncthreads();
}

struct Args { const float* in[18]; float* out; unsigned char* ws; int ph_lo, ph_hi; };

__global__ void __launch_bounds__(NTHR, 2) mk_fwd(Args args) {
    extern __shared__ __attribute__((aligned(16))) unsigned char lds_raw[];
    LAS unsigned char* lds = (LAS unsigned char*)lds_raw;
    cg::grid_group grid = cg::this_grid();
    const int tid = threadIdx.x, lane = tid & 63, wave = __builtin_amdgcn_readfirstlane(tid >> 6);
    const int G = gridDim.x, gw = blockIdx.x * NWAVES + wave, NGW = G * NWAVES;
    const int lo = args.ph_lo, hi = args.ph_hi;
    unsigned char* const ws = args.ws;
#define xin (args.in[0])
#define outp (args.out)
#define rstd1 ((float*)(ws + WS_RSTD1))
#define ssq2 ((float*)(ws + WS_SSQ2))
#define ssqE ((float*)(ws + WS_SSQE))
#define ssq3 ((float*)(ws + WS_SSQ3))
#define dec ((float*)(ws + WS_DEC))
#define WinT ((bf16_t*)(ws + WS_WIN))
#define WoutT ((bf16_t*)(ws + WS_WOUT))
#define WupT ((bf16_t*)(ws + WS_WUP))
#define WdownT ((bf16_t*)(ws + WS_WDOWN))
#define WpleT ((bf16_t*)(ws + WS_WPLE))
#define WgateT ((bf16_t*)(ws + WS_WGATE))
#define xb ((bf16_t*)(ws + WS_XB))
#define pb ((bf16_t*)(ws + WS_PB))
#define cglu ((bf16_t*)(ws + WS_CGLU))
#define qb ((bf16_t*)(ws + WS_QB))
#define gs ((bf16_t*)(ws + WS_GS))
#define logf ((_Float16*)(ws + WS_LOGF))
#define vb ((bf16_t*)(ws + WS_VB))
#define Ut ((bf16_t*)(ws + WS_UT))
#define tb ((bf16_t*)(ws + WS_T))
#define yb ((bf16_t*)(ws + WS_Y))
#define eb ((bf16_t*)(ws + WS_E))
#define Aseg ((bf16_t*)(ws + WS_ASEG))
#define Eseg ((bf16_t*)(ws + WS_ESEG))
#define Dseg ((float*)(ws + WS_DSEG))
#define IN(k) (lo <= (k) && (k) < hi)
#ifndef DBG_TS
#define DBG_TS -1
#endif
    volatile LAS unsigned* bar_st = (volatile LAS unsigned*)(lds + 147328 + 64);
    if (tid < 2) bar_st[tid] = 0u;
    __syncthreads();
    XcdBarrier bar; bar.bar = (unsigned*)(ws + WS_BAR); bar.x = 0; bar.st = bar_st;
    if (hi - lo > 1) bar = xcd_barrier_post((unsigned*)(ws + WS_BAR), bar_st);
    volatile LAS unsigned long long* tsw = (volatile LAS unsigned long long*)(lds + 147328);
    if (DBG_TS >= 0 && tid == 0) { tsw[0] = __builtin_amdgcn_s_memrealtime(); tsw[1] = 0ull; }
#define SEAM(k) do { if (IN(k) && IN((k) + 1)) { if (hi > N_PHASES) grid.sync(); else xcd_barrier(bar); } if (DBG_TS >= 0 && tid == 0) { const unsigned long long t_ = __builtin_amdgcn_s_memrealtime(); if ((k) == DBG_TS) tsw[1] = t_ - tsw[0]; tsw[0] = t_; } } while (0)

#define TSMARK(id) do { if (DBG_TS == (id) && tid == 0) tsw[1] = __builtin_amdgcn_s_memrealtime() - tsw[0]; } while (0)
    if (IN(0)) {
        LAS float* scr = (LAS float*)(lds + wave * 16384);
        constexpr int I_IN = (D / 64) * (DIN / 32);
        for (int it = gw; it < I_IN; it += NGW) transpose_item(args.in[3], D, DIN, WinT, 1, args.in[2], scr, it, lane);
        for (int m0 = gw; m0 < M; m0 += 2 * NGW) {
            f32x4 v[2][4];
#pragma unroll
            for (int r = 0; r < 2; ++r) { const int m = m0 + r * NGW; const f32x4* xr = (const f32x4*)(xin + (size_t)m * D) + lane;
#pragma unroll
                for (int j = 0; j < 4; ++j) v[r][j] = __builtin_nontemporal_load(xr + 64 * j); }
#pragma unroll
            for (int r = 0; r < 2; ++r) { const int m = m0 + r * NGW; float sq = 0.f;
#pragma unroll
                for (int j = 0; j < 4; ++j) sq += (v[r][j][0] * v[r][j][0] + v[r][j][1] * v[r][j][1]) + (v[r][j][2] * v[r][j][2] + v[r][j][3] * v[r][j][3]);
                sq = wave_sum(sq);
                if (lane == 0) rstd1[m] = sqrtf(sq * (1.0f / D) + EPS);
                u32x2* o8 = (u32x2*)(xb + (size_t)m * D) + lane;
                const float rs_ = __builtin_amdgcn_rsqf(sq * (1.0f / D) + EPS);
#pragma unroll
                for (int j = 0; j < 4; ++j) { u32x2 w; w.x = cvt_pk_bf16(v[r][j][0] * rs_, v[r][j][1] * rs_); w.y = cvt_pk_bf16(v[r][j][2] * rs_, v[r][j][3] * rs_); o8[64 * j] = w; } }
        }
        for (int i = blockIdx.x * NTHR + tid; i < M; i += G * NTHR) { ssq2[i] = 0.f; ssqE[i] = 0.f; ssq3[i] = 0.f; }
        __syncthreads();
    }
    SEAM(0);

    if (IN(1)) {
        { pg8::Gemm g{xb, WinT, M, DIN, D}; pg8::StaticOrder S; S.init(M, DIN, G, (int)blockIdx.x);
          pg8::EpiIn E{rstd1, args.in[8], cglu, qb, gs, logf, vb};
          pg8::gemm_phase<pg8::EpiIn, pg8::StaticOrder, true, true>(lds, g, S, E); }
    }
    SEAM(1);

    if (IN(2)) {
        {
            LAS float* scr = (LAS float*)(lds + wave * 15872);
            constexpr int I_OUT = (D / 64) * (D / 32), I_UP = (D / 64) * (FF / 32), I_DOWN = (FF / 64) * (D / 32), I_PLE = (PLE / 64) * (D / 32), I_GATE = I_OUT;
            constexpr int NIT2 = I_OUT + I_UP + I_DOWN + I_PLE + I_GATE;
            for (int it = gw; it < NIT2; it += NGW) {
                int r = it;
                if (r < I_OUT) { transpose_item(args.in[10], D, D, WoutT, 0, nullptr, scr, r, lane); continue; } r -= I_OUT;
                if (r < I_UP) { transpose_item(args.in[12], D, FF, WupT, 0, args.in[11], scr, r, lane); continue; } r -= I_UP;
                if (r < I_DOWN) { transpose_item(args.in[13], FF, D, WdownT, 0, nullptr, scr, r, lane); continue; } r -= I_DOWN;
                if (r < I_PLE) { transpose_item(args.in[14], PLE, D, WpleT, 0, nullptr, scr, r, lane); continue; } r -= I_PLE;
                transpose_item(args.in[16], D, D, WgateT, 0, nullptr, scr, r, lane);
            }
            for (int m0 = gw; m0 < M; m0 += 4 * NGW) {
                f32x4 pv[4];
#pragma unroll
                for (int r = 0; r < 4; ++r) pv[r] = __builtin_nontemporal_load((const f32x4*)(args.in[1] + (size_t)(m0 + r * NGW) * PLE) + lane);
#pragma unroll
                for (int r = 0; r < 4; ++r) { u32x2 w; w.x = cvt_pk_bf16(pv[r][0], pv[r][1]); w.y = cvt_pk_bf16(pv[r][2], pv[r][3]); *((u32x2*)(pb + (size_t)(m0 + r * NGW) * PLE) + lane) = w; }
            }
        }
        {
            typedef float f32x2 __attribute__((ext_vector_type(2)));
            LAS bf16_t* Xs = (LAS bf16_t*)(lds + wave * 15872);
            const float* cw = args.in[4]; const float* cbias = args.in[5]; const float* lng = args.in[6]; const float* lnb = args.in[7];
            const int cb = gw & 3, ch = cb * 128 + 2 * lane;
            f32x2 wj[31];
#pragma unroll
            for (int j = 0; j < 31; ++j) wj[j] = *(const f32x2*)(cw + j * DC + ch);
            const f32x2 bias = *(const f32x2*)(cbias + ch), gg = *(const f32x2*)(lng + ch), bb = *(const f32x2*)(lnb + ch);
            for (int uidx = gw; uidx < (M / 32) * 4; uidx += NGW) {
                const int tile = uidx >> 2, b = tile >> 7, t0 = (tile & 127) * 32;
                const int rr = lane >> 4, c16 = lane & 15;
#pragma unroll 4
                for (int it = 0; it < 16; ++it) { const int i = it * 4 + rr; const int t = t0 - 30 + i;
                    if (i < 62) { u32x4 v = {0u, 0u, 0u, 0u}; if (t >= 0) v = __builtin_nontemporal_load((const u32x4*)(cglu + ((size_t)b * SEQ + t) * DC + cb * 128 + c16 * 8));
                        *(LAS u32x4*)(Xs + i * 128 + c16 * 8) = v; } }
                LDS_WAIT();
                for (int tblk = 0; tblk < 8; ++tblk) {
                    f32x2 xs[34];
#pragma unroll
                    for (int i = 0; i < 34; ++i) { const unsigned w = *(const LAS unsigned*)(Xs + (tblk * 4 + i) * 128 + 2 * lane); xs[i] = (f32x2){bflo(w), bfhi(w)}; }
                    f32x2 av[4]; float s1[4], s2[4];
#pragma unroll
                    for (int o = 0; o < 4; ++o) { f32x2 a = bias;
#pragma unroll
                        for (int j = 0; j < 31; ++j) a = __builtin_elementwise_fma(wj[j], xs[o + j], a);
                        av[o] = a; s1[o] = a.x + a.y; s2[o] = a.x * a.x + a.y * a.y; }
#pragma unroll
                    for (int st = 1; st < 32; st <<= 1) {
#pragma unroll
                        for (int o = 0; o < 4; ++o) { s1[o] += __shfl_xor(s1[o], st); s2[o] += __shfl_xor(s2[o], st); } }
#pragma unroll
                    for (int o = 0; o < 4; ++o) { const float mu = s1[o] * (1.0f / 64.0f); const float var = fmaxf(s2[o] * (1.0f / 64.0f) - mu * mu, 0.f);
                        const float rs = __builtin_amdgcn_rsqf(var + EPS);
                        f32x2 yv = (av[o] - mu) * rs * gg + bb; yv.x = yv.x * sigm(yv.x); yv.y = yv.y * sigm(yv.y);
                        *(unsigned*)(yb + ((size_t)b * SEQ + t0 + tblk * 4 + o) * D + ch) = cvt_pk_bf16(yv.x, yv.y); }
                }
                LDS_WAIT();
            }
        }
        __syncthreads();
        {
            LAS bf16_t* Kt = (LAS bf16_t*)(lds);
            LAS bf16_t* Vt = (LAS bf16_t*)(lds + 18432);
            LAS float* PT = (LAS float*)(lds + 57344);
            LAS float* DEC = (LAS float*)(lds + 38912);
            LAS _Float16* RawLF = (LAS _Float16*)(lds + 40960);
            const int dp = tid & 63, part = tid >> 6, l15 = lane & 15, lq = lane >> 4;
            typedef _Float16 h2v __attribute__((ext_vector_type(2)));
            u32x4 lfr[2], vvn[2];
#define H1_LOAD(unit_) do { const int c_ = (unit_) & 63, bh_ = (unit_) >> 6, h_ = bh_ & 3, b_ = bh_ >> 2; const size_t r0_ = (size_t)b_ * SEQ + 64 * c_; \
                _Pragma("unroll") for (int it = 0; it < 2; ++it) { const int idx = tid + 512 * it; lfr[it] = *(const u32x4*)(logf + (r0_ + (idx >> 4)) * DR + h_ * HD + (idx & 15) * 8); } \
                _Pragma("unroll") for (int it = 0; it < 2; ++it) { const int idx = tid + 512 * it, s = idx >> 4, e8 = idx & 15; vvn[it] = *(const u32x4*)(vb + (r0_ + s) * DR + h_ * HD + e8 * 8); } } while (0)
            const int segid = (int)blockIdx.x;
            const int unit0 = ((segid >> 3) << 6) | ((segid & 7) << 3);
            f32x4 Srun[8];
#pragma unroll
            for (int et = 0; et < 8; ++et) Srun[et] = (f32x4){0.f, 0.f, 0.f, 0.f};
            float dpre0 = 1.0f, dpre1 = 1.0f;
            const int d0 = 16 * wave;
            if (segid < BATCH * NH * 8) {
            H1_LOAD(unit0);
            for (int k = 0; k < 8; ++k) { const int unit = unit0 + k;
                float lf[16]; u32x4 vv[2];
#pragma unroll
                for (int it = 0; it < 2; ++it) { const int idx = tid + 512 * it; *(LAS u32x4*)(RawLF + (idx >> 4) * 128 + (idx & 15) * 8) = lfr[it]; }
                vv[0] = vvn[0]; vv[1] = vvn[1];
#pragma unroll
                for (int it = 0; it < 2; ++it) { const int idx = tid + 512 * it, s = idx >> 4, e8 = idx & 15;
#pragma unroll
                    for (int j = 0; j < 4; ++j) { const unsigned w = vv[it][j]; Vt[(e8 * 8 + 2 * j) * 72 + (s ^ ((e8 & 7) << 3))] = (bf16_t)(w & 0xffffu); Vt[(e8 * 8 + 2 * j + 1) * 72 + (s ^ ((e8 & 7) << 3))] = (bf16_t)(w >> 16); } }
                if (k + 1 < 8) H1_LOAD(unit + 1);
                __syncthreads();
                float lf0[8], lf1[8], bc0[8], bc1[8]; float run0 = 0.f, run1 = 0.f;
#pragma unroll
                for (int i = 0; i < 8; ++i) { const f32x2_t v2 = __builtin_convertvector(__builtin_bit_cast(h2v, *(const LAS unsigned*)(RawLF + (8 * part + i) * 128 + 2 * dp)), f32x2_t);
                    lf0[i] = v2.x; lf1[i] = v2.y; run0 += v2.x; run1 += v2.y; bc0[i] = run0; bc1[i] = run1; }
                *(LAS f32x2_t*)(PT + part * 128 + 2 * dp) = (f32x2_t){run0, run1};
                __syncthreads();
                float off0 = 0.f, off1 = 0.f;
#pragma unroll
                for (int p = 0; p < 7; ++p) if (p < part) { const f32x2_t pv = *(const LAS f32x2_t*)(PT + p * 128 + 2 * dp); off0 += pv.x; off1 += pv.y; }
                unsigned k0w[4], k1w[4];
#pragma unroll
                for (int i = 0; i < 8; i += 2) { const float ba = bc0[i] + off0, bb_ = bc0[i + 1] + off0, bc_ = bc1[i] + off1, bd = bc1[i + 1] + off1;
                    k0w[i >> 1] = cvt_pk_bf16((1.0f - __expf(lf0[i])) * __expf(-ba), (1.0f - __expf(lf0[i + 1])) * __expf(-bb_));
                    k1w[i >> 1] = cvt_pk_bf16((1.0f - __expf(lf1[i])) * __expf(-bc_), (1.0f - __expf(lf1[i + 1])) * __expf(-bd)); }
                *(LAS u32x4*)(Kt + (2 * dp) * 72 + 8 * part) = (u32x4){k0w[0], k0w[1], k0w[2], k0w[3]};
                *(LAS u32x4*)(Kt + (2 * dp + 1) * 72 + 8 * part) = (u32x4){k1w[0], k1w[1], k1w[2], k1w[3]};
                if (part == 7) { const float dc0 = __expf(bc0[7] + off0), dc1 = __expf(bc1[7] + off1); *(LAS f32x2_t*)(DEC + 2 * dp) = (f32x2_t){dc0, dc1}; dpre0 *= dc0; dpre1 *= dc1; }
                __syncthreads();
                bf16x8 a[2];
#pragma unroll
                for (int kk = 0; kk < 2; ++kk) a[kk] = *(const LAS bf16x8*)(Kt + (d0 + l15) * 72 + 8 * lq + 32 * kk);
                const f32x4 dv = *(const LAS f32x4*)(DEC + d0 + 4 * lq);
#pragma unroll
                for (int et = 0; et < 8; ++et) { f32x4 acc = {0.f, 0.f, 0.f, 0.f};
#pragma unroll
                    for (int kk = 0; kk < 2; ++kk) { const bf16x8 bf = *(const LAS bf16x8*)(Vt + (16 * et + l15) * 72 + 8 * ((lq + 4 * kk) ^ ((2 * et + (l15 >> 3)) & 7))); acc = __builtin_amdgcn_mfma_f32_16x16x32_bf16(a[kk], bf, acc, 0, 0, 0); }
                    Srun[et] = dv * (Srun[et] + acc); }
                __syncthreads();
            }
#pragma unroll
            for (int et = 0; et < 8; ++et) { u32x2 w2; w2.x = cvt_pk_bf16(Srun[et][0], Srun[et][1]); w2.y = cvt_pk_bf16(Srun[et][2], Srun[et][3]);
                *(u32x2*)(Aseg + (size_t)segid * (HD * HD) + (16 * et + l15) * HD + d0 + 4 * lq) = w2; }
            if (part == 7) *(f32x2_t*)(Dseg + segid * HD + 2 * dp) = (f32x2_t){dpre0, dpre1};
            }
        }
    }
    SEAM(2);

    if (IN(3)) {
        for (int idx = blockIdx.x * NTHR + tid; idx < BATCH * NH * HD * (HD / 4); idx += G * NTHR) {
            const int bh = idx >> 12, el = idx & 4095, d4 = el & 31;
            float E0 = 0.f, E1 = 0.f, E2 = 0.f, E3 = 0.f;
#pragma unroll
            for (int j = 0; j < 8; ++j) { const size_t o = (size_t)(bh * 8 + j) * (HD * HD) + (size_t)el * 4;
                const u32x2 av = *(const u32x2*)(Aseg + o); const f32x4 dv = *(const f32x4*)(Dseg + (bh * 8 + j) * HD + d4 * 4);
                u32x2 sv; sv.x = cvt_pk_bf16(E0, E1); sv.y = cvt_pk_bf16(E2, E3); *(u32x2*)(Eseg + o) = sv;
                E0 = bflo(av.x) + dv[0] * E0; E1 = bfhi(av.x) + dv[1] * E1; E2 = bflo(av.y) + dv[2] * E2; E3 = bfhi(av.y) + dv[3] * E3; }
        }
    }
    SEAM(3);

    if (IN(4)) {
        LAS bf16_t* Qs = (LAS bf16_t*)(lds);
        LAS bf16_t* Ks = (LAS bf16_t*)(lds + 17408);
        LAS bf16_t* Vt = (LAS bf16_t*)(lds + 34816);
        LAS bf16_t* St = (LAS bf16_t*)(lds + 53248);
        LAS bf16_t* As = (LAS bf16_t*)(lds + 88064);
        LAS float* PT = (LAS float*)(lds + 135168);
        LAS float* SS = (LAS float*)(lds + 99328);
        LAS _Float16* RawLF = (LAS _Float16*)(lds);
        LAS bf16_t* RawQ = (LAS bf16_t*)(lds + 99840);
        LAS bf16_t* Kt = (LAS bf16_t*)(lds + 116224);
        LAS float* DEC = (LAS float*)(lds + 134656);
        const float* recg = args.in[9];
        const int dp = tid & 63, part = tid >> 6, l15 = lane & 15, lq = lane >> 4;
        typedef _Float16 h2v __attribute__((ext_vector_type(2)));
        u32x4 lfr[2], qr[2], vvn[2]; u32x2 gvn[4]; f32x4 rgn[4];
        const int o_tt = wave & 3, o_eh = wave >> 2;
#define H3_LOAD(unit_) do { const int c_ = (unit_) & 63, bh_ = (unit_) >> 6, h_ = bh_ & 3, b_ = bh_ >> 2; const size_t r0_ = (size_t)b_ * SEQ + 64 * c_; \
            _Pragma("unroll") for (int it = 0; it < 2; ++it) { const int idx = tid + 512 * it; lfr[it] = __builtin_nontemporal_load((const u32x4*)(logf + (r0_ + (idx >> 4)) * DR + h_ * HD + (idx & 15) * 8)); } \
            _Pragma("unroll") for (int it = 0; it < 2; ++it) { const int idx = tid + 512 * it; qr[it] = __builtin_nontemporal_load((const u32x4*)(qb + (r0_ + (idx >> 4)) * DR + h_ * HD + (idx & 15) * 8)); } \
            _Pragma("unroll") for (int it = 0; it < 2; ++it) { const int idx = tid + 512 * it, s = idx >> 4, e8 = idx & 15; vvn[it] = __builtin_nontemporal_load((const u32x4*)(vb + (r0_ + s) * DR + h_ * HD + e8 * 8)); } \
            _Pragma("unroll") for (int et = 0; et < 4; ++et) { const int e_ = 16 * (4 * o_eh + et) + 4 * lq; gvn[et] = __builtin_nontemporal_load((const u32x2*)(gs + (r0_ + 16 * o_tt + l15) * DR + h_ * HD + e_)); } } while (0)
        const int segid = (int)blockIdx.x, unit0 = ((segid >> 3) << 6) | ((segid & 7) << 3);
        if (segid < BATCH * NH * 8) {
        const int d0 = 16 * wave;
        f32x4 Srun[8];
#pragma unroll
        for (int et = 0; et < 8; ++et) { const u32x2 ev = *(const u32x2*)(Eseg + (size_t)segid * (HD * HD) + (16 * et + l15) * HD + d0 + 4 * lq); Srun[et] = (f32x4){bflo(ev.x), bfhi(ev.x), bflo(ev.y), bfhi(ev.y)}; }
#pragma unroll
        for (int et = 0; et < 4; ++et) rgn[et] = *(const f32x4*)(recg + ((segid >> 3) & 3) * HD + 16 * (4 * o_eh + et) + 4 * lq);
        H3_LOAD(unit0);
        for (int k8 = 0; k8 < 8; ++k8) { const int unit = unit0 + k8;
            const int c = unit & 63, bh = unit >> 6, h = bh & 3, b = bh >> 2; const size_t r0 = (size_t)b * SEQ + 64 * c;
            float lf[16]; float qv[16]; u32x4 vv[2];
#pragma unroll
            for (int it = 0; it < 2; ++it) { const int idx = tid + 512 * it; *(LAS u32x4*)(RawLF + (idx >> 4) * 128 + (idx & 15) * 8) = lfr[it]; }
#pragma unroll
            for (int it = 0; it < 2; ++it) { const int idx = tid + 512 * it; *(LAS u32x4*)(RawQ + (idx >> 4) * 128 + (idx & 15) * 8) = qr[it]; }
            vv[0] = vvn[0]; vv[1] = vvn[1];
#pragma unroll
            for (int et = 0; et < 8; ++et) { u32x2 w2; w2.x = cvt_pk_bf16(Srun[et][0], Srun[et][1]); w2.y = cvt_pk_bf16(Srun[et][2], Srun[et][3]); *(LAS u32x2*)(St + (16 * et + l15) * 136 + d0 + 4 * lq) = w2; }
            u32x2 gv[4]; f32x4 rgv[4];
#pragma unroll
            for (int et = 0; et < 4; ++et) { gv[et] = gvn[et]; rgv[et] = rgn[et]; }
#pragma unroll
            for (int it = 0; it < 2; ++it) { const int idx = tid + 512 * it, s = idx >> 4, e8 = idx & 15;
#pragma unroll
                for (int j = 0; j < 4; ++j) { const unsigned w = vv[it][j]; Vt[(e8 * 8 + 2 * j) * 72 + (s ^ ((e8 & 7) << 3))] = (bf16_t)(w & 0xffffu); Vt[(e8 * 8 + 2 * j + 1) * 72 + (s ^ ((e8 & 7) << 3))] = (bf16_t)(w >> 16); } }
            if (k8 + 1 < 8) H3_LOAD(unit + 1);
            __syncthreads();
            float lf0[8], lf1[8], q0[8], q1[8], bc0[8], bc1[8]; float run0 = 0.f, run1 = 0.f;
#pragma unroll
            for (int i = 0; i < 8; ++i) { const f32x2_t v2 = __builtin_convertvector(__builtin_bit_cast(h2v, *(const LAS unsigned*)(RawLF + (8 * part + i) * 128 + 2 * dp)), f32x2_t);
                const unsigned qw = *(const LAS unsigned*)(RawQ + (8 * part + i) * 128 + 2 * dp); q0[i] = bflo(qw); q1[i] = bfhi(qw);
                lf0[i] = v2.x; lf1[i] = v2.y; run0 += v2.x; run1 += v2.y; bc0[i] = run0; bc1[i] = run1; }
            *(LAS f32x2_t*)(PT + part * 128 + 2 * dp) = (f32x2_t){run0, run1};
            __syncthreads();
            float off0 = 0.f, off1 = 0.f;
#pragma unroll
            for (int p = 0; p < 7; ++p) if (p < part) { const f32x2_t pv = *(const LAS f32x2_t*)(PT + p * 128 + 2 * dp); off0 += pv.x; off1 += pv.y; }
            unsigned k0w[4], k1w[4];
#pragma unroll
            for (int i = 0; i < 8; i += 2) {
                float kk0[2], kk1[2];
#pragma unroll
                for (int u2 = 0; u2 < 2; ++u2) { const float ba = bc0[i + u2] + off0, bb_ = bc1[i + u2] + off1;
                    const float qa = q0[i + u2] * __expf(ba), qb_ = q1[i + u2] * __expf(bb_);
                    kk0[u2] = (1.0f - __expf(lf0[i + u2])) * __expf(-ba); kk1[u2] = (1.0f - __expf(lf1[i + u2])) * __expf(-bb_);
                    *(LAS unsigned*)(Qs + (8 * part + i + u2) * 136 + 2 * dp) = cvt_pk_bf16(qa, qb_);
                    *(LAS unsigned*)(Ks + (8 * part + i + u2) * 136 + 2 * dp) = cvt_pk_bf16(kk0[u2], kk1[u2]); }
                k0w[i >> 1] = cvt_pk_bf16(kk0[0], kk0[1]); k1w[i >> 1] = cvt_pk_bf16(kk1[0], kk1[1]); }
            *(LAS u32x4*)(Kt + (2 * dp) * 72 + 8 * part) = (u32x4){k0w[0], k0w[1], k0w[2], k0w[3]};
            *(LAS u32x4*)(Kt + (2 * dp + 1) * 72 + 8 * part) = (u32x4){k1w[0], k1w[1], k1w[2], k1w[3]};
            if (part == 7) *(LAS f32x2_t*)(DEC + 2 * dp) = (f32x2_t){__expf(bc0[7] + off0), __expf(bc1[7] + off1)};
            __syncthreads();
            {
                bf16x8 ka[2];
#pragma unroll
                for (int kk = 0; kk < 2; ++kk) ka[kk] = *(const LAS bf16x8*)(Kt + (d0 + l15) * 72 + 8 * lq + 32 * kk);
                const f32x4 dv = *(const LAS f32x4*)(DEC + d0 + 4 * lq);
#pragma unroll
                for (int et = 0; et < 8; ++et) { f32x4 acc = {0.f, 0.f, 0.f, 0.f};
#pragma unroll
                    for (int kk = 0; kk < 2; ++kk) { const bf16x8 bf = *(const LAS bf16x8*)(Vt + (16 * et + l15) * 72 + 8 * ((lq + 4 * kk) ^ ((2 * et + (l15 >> 3)) & 7))); acc = __builtin_amdgcn_mfma_f32_16x16x32_bf16(ka[kk], bf, acc, 0, 0, 0); }
                    Srun[et] = dv * (Srun[et] + acc); }
            }
            {
                const int tt = wave >> 1;
#pragma unroll
                for (int sti = 0; sti < 2; ++sti) { const int st = 2 * (wave & 1) + sti; f32x4 acc = {0.f, 0.f, 0.f, 0.f};
                    if (st <= tt) {
#pragma unroll
                        for (int kk = 0; kk < 4; ++kk) { const bf16x8 ak = *(const LAS bf16x8*)(Ks + (16 * st + l15) * 136 + 8 * lq + 32 * kk); const bf16x8 bq = *(const LAS bf16x8*)(Qs + (16 * tt + l15) * 136 + 8 * lq + 32 * kk);
                            acc = __builtin_amdgcn_mfma_f32_16x16x32_bf16(ak, bq, acc, 0, 0, 0); } }
                    const int t = 16 * tt + l15, s0 = 16 * st + 4 * lq;
#pragma unroll
                    for (int r = 0; r < 4; ++r) if (s0 + r > t) acc[r] = 0.f;
                    u32x2 w2; w2.x = cvt_pk_bf16(acc[0], acc[1]); w2.y = cvt_pk_bf16(acc[2], acc[3]);
                    *(LAS u32x2*)(As + t * 72 + s0) = w2; }
            }
            __syncthreads();
            {
                const int tt = wave & 3, eh = wave >> 2, t = 16 * tt + l15;
                bf16x8 bA[2], bQ[4];
#pragma unroll
                for (int kk = 0; kk < 2; ++kk) bA[kk] = *(const LAS bf16x8*)(As + t * 72 + 8 * lq + 32 * kk);
#pragma unroll
                for (int kk = 0; kk < 4; ++kk) bQ[kk] = *(const LAS bf16x8*)(Qs + t * 136 + 8 * lq + 32 * kk);
                f32x4 o[4]; float ss = 0.f;
#pragma unroll
                for (int et = 0; et < 4; ++et) { const int e0 = 16 * (4 * eh + et);
                    f32x4 acc = {0.f, 0.f, 0.f, 0.f};
#pragma unroll
                    for (int kk = 0; kk < 2; ++kk) { const bf16x8 av = *(const LAS bf16x8*)(Vt + (e0 + l15) * 72 + 8 * ((lq + 4 * kk) ^ (((e0 >> 3) + (l15 >> 3)) & 7))); acc = __builtin_amdgcn_mfma_f32_16x16x32_bf16(av, bA[kk], acc, 0, 0, 0); }
#pragma unroll
                    for (int kk = 0; kk < 4; ++kk) { const bf16x8 as = *(const LAS bf16x8*)(St + (e0 + l15) * 136 + 8 * lq + 32 * kk); acc = __builtin_amdgcn_mfma_f32_16x16x32_bf16(as, bQ[kk], acc, 0, 0, 0); }
                    o[et] = acc; ss += (acc[0] * acc[0] + acc[1] * acc[1]) + (acc[2] * acc[2] + acc[3] * acc[3]); }
                ss += __shfl_xor(ss, 16); ss += __shfl_xor(ss, 32);
                if (lq == 0) SS[t * 2 + eh] = ss;
                __syncthreads();
                const float rs = __builtin_amdgcn_rsqf((SS[t * 2] + SS[t * 2 + 1]) * (1.0f / HD) + EPS);
#pragma unroll
                for (int et = 0; et < 4; ++et) { const int e = 16 * (4 * eh + et) + 4 * lq; const f32x4 rg = rgv[et];
                    const float y0 = o[et][0] * rs * rg[0] * bflo(gv[et].x), y1 = o[et][1] * rs * rg[1] * bfhi(gv[et].x), y2 = o[et][2] * rs * rg[2] * bflo(gv[et].y), y3 = o[et][3] * rs * rg[3] * bfhi(gv[et].y);
                    u32x2 w2; w2.x = cvt_pk_bf16(y0, y1); w2.y = cvt_pk_bf16(y2, y3);
                    *(u32x2*)(yb + (r0 + t) * D + DC + h * HD + e) = w2; }
            }
            __syncthreads();
        }
        }
    }
    SEAM(4);

    if (IN(5)) { pg8::Gemm g{yb, WoutT, M, D, D}; pg8::StaticOrder S; S.init(M, D, G, (int)blockIdx.x);
        pg8::EpiOut E{xb, ssq2, rstd1};
        pg8::gemm_phase<pg8::EpiOut, pg8::StaticOrder, true, true>(lds, g, S, E);
        { pg8::Gemm g{pb, WpleT, M, D, PLE}; pg8::StaticOrder S; S.init(M, D, G, (int)blockIdx.x);
          pg8::EpiPle E{eb, ssqE};
          pg8::gemm_phase<pg8::EpiPle, pg8::StaticOrder, true, true>(lds, g, S, E); }
    }
    SEAM(5);
    if (IN(6)) { pg8::Gemm g{xb, WupT, M, FF, D}; pg8::StaticOrder S; S.init(M, FF, G, (int)blockIdx.x);
        pg8::EpiUp E{tb};
        pg8::gemm_phase<pg8::EpiUp, pg8::StaticOrder, true, true>(lds, g, S, E); }
    SEAM(6);
    if (IN(7)) { pg8::Gemm g{tb, WdownT, M, D, FF}; pg8::StaticOrder S; S.init(M, D, G, (int)blockIdx.x);
        pg8::EpiDown E{ssq2, xb};
        pg8::gemm_phase<pg8::EpiDown, pg8::StaticOrder, true, true>(lds, g, S, E); }
    SEAM(7);
    if (IN(8)) { pg8::Gemm g{xb, WgateT, M, D, D}; pg8::StaticOrder S; S.init(M, D, G, (int)blockIdx.x);
        pg8::EpiGateFinal E{outp, xb, eb, ssqE, args.in[15], ssq3, (unsigned*)(ws + WS_PCNT), args.in[17]};
        pg8::gemm_phase<pg8::EpiGateFinal, pg8::StaticOrder, true, true>(lds, g, S, E); }
    if (DBG_TS >= 0) { xcd_barrier(bar); if (blockIdx.x == 0 && tid == 0) { if (DBG_TS == 8) tsw[1] = __builtin_amdgcn_s_memrealtime() - tsw[0]; outp[0] = 4.0f * rintf((float)tsw[1] * 0.01f * 0.25f); } }
#undef IN
#undef SEAM
}

#ifndef DBG_STOP
#define DBG_STOP -1
#endif
#ifndef DBG_OFF
#define DBG_OFF (WS_LOGF + 32 * MiB)
#endif
__global__ void dbg_dump(const unsigned short* src, float* o, int n) { for (int i = blockIdx.x * blockDim.x + threadIdx.x; i < n; i += gridDim.x * blockDim.x) o[i] = (float)src[i]; }
extern "C" void kernel_launch(void* const* d_in, const int* in_sizes, int n_in, void* d_out, int out_size, void* d_ws, size_t ws_size, hipStream_t stream) {
    static int grid = 0;
    if (grid == 0) {
        if (n_in != 18 || in_sizes[0] != M * D || out_size != M * D || ws_size < WS_END) { fprintf(stderr, "kernel_launch: unexpected shapes (n_in %d, in0 %d, out %d, ws %zu)\n", n_in, n_in > 0 ? in_sizes[0] : -1, out_size, ws_size); grid = -1; return; }
        int dev = 0, cus = 0, per_cu = 0;
        hipGetDevice(&dev); hipDeviceGetAttribute(&cus, hipDeviceAttributeMultiprocessorCount, dev);
        if (hipFuncSetAttribute((const void*)mk_fwd, hipFuncAttributeMaxDynamicSharedMemorySize, LDS_BYTES) != hipSuccess) { fprintf(stderr, "kernel_launch: hipFuncSetAttribute failed\n"); grid = -1; return; }
        if (hipOccupancyMaxActiveBlocksPerMultiprocessor(&per_cu, (const void*)mk_fwd, NTHR, LDS_BYTES) != hipSuccess || per_cu < 1) { fprintf(stderr, "kernel_launch: occupancy query says %d\n", per_cu); per_cu = 1; }
        (void)hipGetLastError();
        grid = cus;
    }
    if (grid < 0) return;
    Args a{};
    for (int i = 0; i < 18; ++i) a.in[i] = (const float*)d_in[i];
    a.out = (float*)d_out; a.ws = (unsigned char*)d_ws;
#if MK_COOP
    if (hipMemsetAsync((char*)d_ws + WS_BAR, 0, 96 * 1024, stream) != hipSuccess) { fprintf(stderr, "kernel_launch: memset of the barrier words failed\n"); return; }
    a.ph_lo = 0; a.ph_hi = N_PHASES;
    void* kargs[] = {&a};
    hipError_t e = hipLaunchCooperativeKernel((const void*)mk_fwd, dim3(grid), dim3(NTHR), kargs, LDS_BYTES, stream);
    if (e != hipSuccess) fprintf(stderr, "cooperative launch failed: %s (grid %d)\n", hipGetErrorString(e), grid);
#else
    for (int p = 0; p < N_PHASES; ++p) { if (DBG_STOP >= 0 && p > DBG_STOP) break; a.ph_lo = p; a.ph_hi = p + 1; hipLaunchKernelGGL(mk_fwd, dim3(grid), dim3(NTHR), LDS_BYTES, stream, a); }
    if (DBG_STOP >= 0) hipLaunchKernelGGL(dbg_dump, dim3(2048), dim3(256), 0, stream, (const unsigned short*)((unsigned char*)d_ws + DBG_OFF), (float*)d_out, M * D);
#endif
}
```
